# Optimizing an MI355X kernel written in HIP

```python
import math
import jax, jax.numpy as jnp
from jax import lax
import numpy as np

D_MODEL = 1024
BATCH = 16
SEQ = 2048
DEPTH = 4

HEAD_DIM = 128
ROT_DIM = HEAD_DIM // 4
ROPE_THETA = 500000.0
DIL_PAIRS = ((128, 1), (512, 4), (2048, 16))
N_GROUPS = len(DIL_PAIRS)
A_HEADS = D_MODEL // HEAD_DIM
A_WIDTH = A_HEADS * HEAD_DIM
A_QKV = N_GROUPS * A_WIDTH
B_HEADS = D_MODEL // HEAD_DIM
B_KEY = 128
B_VAL = 128
B_WIDTH = B_HEADS * B_VAL
CHUNK = 64
MEM_LEN = 256
MEM_HEADS = 4
MEM_WIDTH = MEM_HEADS * HEAD_DIM
MIX_WIDTH = A_WIDTH + MEM_WIDTH
IN_A = 3 * A_QKV + MEM_WIDTH + MIX_WIDTH
IN_B = 3 * B_HEADS * B_KEY + MEM_WIDTH + MIX_WIDTH
N_A_LAYERS = (DEPTH + 1) // 2
N_B_LAYERS = DEPTH // 2
EPS = 1e-6
ATTN_SCALE = 1.0 / math.sqrt(HEAD_DIM)

kernel_name = "hybrid_dilated_attn_hgrn2_memxattn"


def rms_norm(x, g):
    xf = x.astype(jnp.float32)
    y = xf * lax.rsqrt(jnp.mean(xf * xf, axis=-1, keepdims=True) + EPS)
    return (y * g.astype(jnp.float32)).astype(x.dtype)


def rotary_tables(positions):
    inv_freq = ROPE_THETA ** (-jnp.arange(0, ROT_DIM, 2, dtype=jnp.float32) / ROT_DIM)
    ang = positions.astype(jnp.float32)[..., None] * inv_freq
    return jnp.cos(ang), jnp.sin(ang)


def apply_partial_rotary(x, cos, sin):
    xf = x.astype(jnp.float32)
    half = ROT_DIM // 2
    x1, x2, rest = xf[..., :half], xf[..., half:ROT_DIM], xf[..., ROT_DIM:]
    out = jnp.concatenate([x1 * cos - x2 * sin, x2 * cos + x1 * sin, rest], axis=-1)
    return out.astype(x.dtype)


def dilated_window_attention(q, k, v, dilation, n_back):
    B, S, H, Dh = q.shape
    span = dilation * n_back
    Sp = -(-S // span) * span
    nb = Sp // span

    def to_blocks(t):
        t = jnp.pad(t, ((0, 0), (0, Sp - S), (0, 0), (0, 0)))
        return t.reshape(B, nb, n_back, dilation, H, Dh).transpose(0, 3, 1, 2, 4, 5)

    qb, kb, vb = to_blocks(q), to_blocks(k), to_blocks(v)
    shift = lambda t: jnp.pad(t, ((0, 0), (0, 0), (1, 0), (0, 0), (0, 0), (0, 0)))[:, :, :-1]
    kc = jnp.concatenate([shift(kb), kb], axis=3)
    vc = jnp.concatenate([shift(vb), vb], axis=3)
    s = jnp.einsum('brcqhd,brckhd->brchqk', qb, kc).astype(jnp.float32) * ATTN_SCALE
    i = jnp.arange(n_back)[:, None]
    j = jnp.arange(2 * n_back)[None, :]
    dist = n_back + i - j
    band = (dist >= 0) & (dist <= n_back)
    c = jnp.arange(nb)[:, None, None]
    valid = band[None] & ((c * n_back + j[None] - n_back) >= 0)
    valid = valid[None, None, :, None]
    s = jnp.where(valid, s, -jnp.inf)
    m = jnp.max(s, axis=-1, keepdims=True)
    p = jnp.exp(s - m)
    den = jnp.sum(p, axis=-1, keepdims=True)
    o = jnp.einsum('brchqk,brckhd->brcqhd', p.astype(v.dtype), vc).astype(jnp.float32)
    o = o / jnp.moveaxis(den, 3, 4)
    lse = (m + jnp.log(den))[..., 0]
    o = o.transpose(0, 2, 3, 1, 4, 5).reshape(B, Sp, H, Dh)[:, :S]
    lse = lse.transpose(0, 2, 4, 1, 3).reshape(B, Sp, H)[:, :S]
    return o, lse


def dilated_mixer(cols, cos, sin, q_gain, k_gain):
    B, S, _ = cols.shape
    qkv = cols.reshape(B, S, 3, N_GROUPS, A_HEADS, HEAD_DIM)
    q = rms_norm(qkv[:, :, 0], q_gain[:, None, :])
    k = rms_norm(qkv[:, :, 1], k_gain[:, None, :])
    v = qkv[:, :, 2]
    cos5, sin5 = cos[:, :, None, None, :], sin[:, :, None, None, :]
    q = apply_partial_rotary(q, cos5, sin5)
    k = apply_partial_rotary(k, cos5, sin5)
    outs, lses = [], []
    for g, (window, dil) in enumerate(DIL_PAIRS):
        o, lse = dilated_window_attention(q[:, :, g], k[:, :, g], v[:, :, g], dil, window // dil)
        outs.append(o)
        lses.append(lse)
    alpha = jax.nn.softmax(jnp.stack(lses, axis=0), axis=0)
    o = jnp.sum(alpha[..., None] * jnp.stack(outs, axis=0), axis=0)
    return o.reshape(B, S, A_WIDTH).astype(cols.dtype)


def gla_chunk_scan(q, k, v, log_f):
    B, S, H, dk = q.shape
    dv = v.shape[-1]
    nc = S // CHUNK
    to_c = lambda t: t.reshape(B, nc, CHUNK, H, t.shape[-1]).transpose(1, 0, 3, 2, 4)
    qc, kc, vc = to_c(q), to_c(k), to_c(v)
    G = jnp.cumsum(to_c(log_f), axis=3)
    causal = jnp.tril(jnp.ones((CHUNK, CHUNK), dtype=bool))[..., None]

    def step(state, inp):
        qt, kt, vt, Gt = inp
        o_inter = jnp.einsum('bhtk,bhkv->bhtv', qt * jnp.exp(Gt), state)
        diff = Gt[:, :, :, None, :] - Gt[:, :, None, :, :]
        decay = jnp.where(causal, jnp.exp(jnp.where(causal, diff, 0.0)), 0.0)
        attn = jnp.einsum('bhtk,bhsk,bhtsk->bhts', qt, kt, decay)
        o_intra = jnp.einsum('bhts,bhsv->bhtv', attn, vt)
        g_last = Gt[:, :, -1:, :]
        k_dec = kt * jnp.exp(g_last - Gt)
        new_state = jnp.exp(g_last[:, :, 0, :])[..., None] * state + jnp.einsum('bhsk,bhsv->bhkv', k_dec, vt)
        return new_state, o_inter + o_intra

    init = jnp.zeros((B, H, dk, dv), jnp.float32)
    _, o = lax.scan(step, init, (qc, kc, vc, G))
    return o.transpose(1, 0, 3, 2, 4).reshape(B, S, H, dv)


def hgrn2_mixer(cols, lb, o_gain):
    B, S, _ = cols.shape
    w = B_HEADS * B_KEY
    q = cols[..., :w].astype(jnp.float32)
    f = cols[..., w:2 * w].astype(jnp.float32)
    iv = cols[..., 2 * w:].astype(jnp.float32)
    log_f = jnp.logaddexp(jnp.log(lb), jnp.log1p(-lb) + jax.nn.log_sigmoid(f))
    k = (1.0 - lb) * jax.nn.sigmoid(-f)
    sh = lambda t, d: t.reshape(B, S, B_HEADS, d)
    o = gla_chunk_scan(sh(q, B_KEY), sh(k, B_KEY), sh(iv, B_VAL), sh(log_f, B_KEY))
    o = rms_norm(o, o_gain)
    return o.reshape(B, S, B_WIDTH).astype(cols.dtype)


def memory_cross_attention(q_cols, mem, mem_gain, w_kv, q_gain, k_gain):
    B, S, _ = q_cols.shape
    M = mem.shape[1]
    kv = rms_norm(mem, mem_gain) @ w_kv
    km = rms_norm(kv[..., :MEM_WIDTH].reshape(B, M, MEM_HEADS, HEAD_DIM), k_gain)
    vm = kv[..., MEM_WIDTH:].reshape(B, M, MEM_HEADS, HEAD_DIM)
    qm = rms_norm(q_cols.reshape(B, S, MEM_HEADS, HEAD_DIM), q_gain)
    s = jnp.einsum('bshd,bmhd->bhsm', qm, km).astype(jnp.float32) * ATTN_SCALE
    p = jax.nn.softmax(s, axis=-1)
    o = jnp.einsum('bhsm,bmhd->bshd', p.astype(vm.dtype), vm)
    return o.reshape(B, S, MEM_WIDTH)


def setup_inputs(seed: int = 0) -> dict:
    key = jax.random.key(seed)
    ks = jax.random.split(key, 16)
    nrm = lambda k, shape, scale: jax.random.normal(k, shape, jnp.float32) * scale
    gain = lambda k, shape: 1.0 + 0.05 * jax.random.normal(k, shape, jnp.float32)
    x = nrm(ks[0], (BATCH, SEQ, D_MODEL), 1.0)
    mem = nrm(ks[1], (BATCH, MEM_LEN, D_MODEL), 1.0)
    offsets = jax.random.randint(ks[2], (BATCH, 1), 0, 4096, dtype=jnp.int32)
    positions = offsets + jnp.arange(SEQ, dtype=jnp.int32)[None, :]
    return {
        "x": x,
        "mem": mem,
        "positions": positions,
        "norm_gain": gain(ks[3], (DEPTH, D_MODEL)),
        "w_in_a": nrm(ks[4], (N_A_LAYERS, D_MODEL, IN_A), D_MODEL ** -0.5),
        "q_gain_a": gain(ks[5], (N_A_LAYERS, N_GROUPS, HEAD_DIM)),
        "k_gain_a": gain(ks[6], (N_A_LAYERS, N_GROUPS, HEAD_DIM)),
        "w_out_a": nrm(ks[7], (N_A_LAYERS, MIX_WIDTH, D_MODEL), MIX_WIDTH ** -0.5),
        "w_in_b": nrm(ks[8], (N_B_LAYERS, D_MODEL, IN_B), D_MODEL ** -0.5),
        "lb_logits": nrm(ks[9], (DEPTH, B_HEADS * B_KEY), 0.5),
        "o_gain_b": gain(ks[10], (N_B_LAYERS, B_VAL)),
        "w_out_b": nrm(ks[11], (N_B_LAYERS, MIX_WIDTH, D_MODEL), MIX_WIDTH ** -0.5),
        "mem_norm_gain": gain(ks[12], (DEPTH, D_MODEL)),
        "w_mem_kv": nrm(ks[13], (DEPTH, D_MODEL, 2 * MEM_WIDTH), D_MODEL ** -0.5),
        "mem_q_gain": gain(ks[14], (DEPTH, HEAD_DIM)),
        "mem_k_gain": gain(ks[15], (DEPTH, HEAD_DIM)),
    }


def reference(x, mem, positions, norm_gain, w_in_a, q_gain_a, k_gain_a, w_out_a,
              w_in_b, lb_logits, o_gain_b, w_out_b, mem_norm_gain, w_mem_kv,
              mem_q_gain, mem_k_gain):
    cos, sin = rotary_tables(positions)
    sm = jax.nn.softmax(lb_logits.astype(jnp.float32), axis=0)
    lower_bounds = jnp.cumsum(sm, axis=0) - sm[0:1]
    for l in range(DEPTH):
        j = l // 2
        h = rms_norm(x, norm_gain[l])
        if l % 2 == 0:
            cols = h @ w_in_a[j]
            mix = dilated_mixer(cols[..., :3 * A_QKV], cos, sin, q_gain_a[j], k_gain_a[j])
            q_mem = cols[..., 3 * A_QKV:3 * A_QKV + MEM_WIDTH]
            gate = cols[..., 3 * A_QKV + MEM_WIDTH:]
            w_out = w_out_a[j]
        else:
            cols = h @ w_in_b[j]
            wb = 3 * B_HEADS * B_KEY
            mix = hgrn2_mixer(cols[..., :wb], lower_bounds[l], o_gain_b[j])
            q_mem = cols[..., wb:wb + MEM_WIDTH]
            gate = cols[..., wb + MEM_WIDTH:]
            w_out = w_out_b[j]
        mem_out = memory_cross_attention(q_mem, mem, mem_norm_gain[l], w_mem_kv[l],
                                         mem_q_gain[l], mem_k_gain[l])
        y = jnp.concatenate([mix, mem_out], axis=-1) * jax.nn.silu(gate)
        x = x + y @ w_out
    return x
```

```cpp
#include <hip/hip_runtime.h>
#include <hip/hip_cooperative_groups.h>
#include <cstdio>
namespace cg = cooperative_groups;

#define DI __device__ __forceinline__
#define LAS __attribute__((address_space(3)))
typedef unsigned short bf16_t;
typedef short bf16x8 __attribute__((ext_vector_type(8)));
typedef short s16x4 __attribute__((ext_vector_type(4)));
typedef float f32x4 __attribute__((ext_vector_type(4)));
typedef unsigned u32x4 __attribute__((ext_vector_type(4)));
typedef unsigned u32x2 __attribute__((ext_vector_type(2)));

constexpr int T_TOK = 32768, DM = 1024, SEQ = 2048;
constexpr int IN_A = 11264, IN_B = 5120, MIXW = 1536;
constexpr int NTHREADS = 512;
constexpr int LDS_BYTES = 149504;
constexpr int SSQ_LDS_OFF = 131072;
constexpr float EPS = 1e-6f;
constexpr float QSCALE = 0.12751743082459868f;
constexpr float LN2 = 0.6931471805599453f;

constexpr size_t WS_WIN  = 0;
constexpr size_t WS_WOUT = WS_WIN + (size_t)IN_A * DM * 2;
constexpr size_t WS_XN   = WS_WOUT + (size_t)DM * MIXW * 2;
constexpr size_t WS_KVM  = WS_XN + (size_t)T_TOK * DM * 2;
constexpr size_t WS_MEMN = WS_KVM + (size_t)4096 * 4096 * 2;
constexpr size_t WS_WKV  = WS_MEMN + (size_t)4096 * 1024 * 2;
constexpr size_t WS_LSE  = WS_WKV + (size_t)4096 * 1024 * 2;
constexpr size_t WS_LB   = WS_LSE + (size_t)16384 * 24 * 4;
constexpr size_t WS_COLS = WS_LB + 8192;
constexpr size_t WS_BAR  = WS_COLS + (size_t)16384 * IN_A * 2;
constexpr size_t WS_ROT  = WS_BAR + 16384;
constexpr size_t WS_SSQ  = WS_ROT + (size_t)T_TOK * 32 * 4;
constexpr size_t WS_WOUT2 = WS_SSQ + (size_t)T_TOK * 16 * 4;
constexpr size_t WS_END  = WS_WOUT2 + (size_t)DM * MIXW * 2;

struct Params { const float* in[16]; float* out; unsigned char* ws; };

#define GAS __attribute__((address_space(1)))
template <class T> DI const GAS T* launder_g(const T* p) { asm volatile("" : "+s"(p)); return (const GAS T*)p; }
DI int launder_tid() { int t = threadIdx.x; asm volatile("" : "+v"(t)); return t; }
DI float bf2f(unsigned short h) { return __uint_as_float(((unsigned)h) << 16); }
DI float bflo(unsigned u) { return __uint_as_float(u << 16); }
DI float bfhi(unsigned u) { return __uint_as_float(u & 0xffff0000u); }
typedef __bf16 bf16x2_t __attribute__((ext_vector_type(2)));
typedef float f32x2_t __attribute__((ext_vector_type(2)));
DI unsigned pk2(float lo, float hi) { const f32x2_t v = {lo, hi}; const bf16x2_t b = __builtin_convertvector(v, bf16x2_t); return __builtin_bit_cast(unsigned, b); }
DI unsigned short f2bf(float x) { return (unsigned short)(pk2(x, x) & 0xffffu); }
DI u32x4 swap16_pack(u32x2 a, u32x2 b) {
    const u32x2 X = __builtin_amdgcn_permlane16_swap(a.x, b.x, false, false);
    const u32x2 Y = __builtin_amdgcn_permlane16_swap(a.y, b.y, false, false);
    return (u32x4){X.x, Y.x, X.y, Y.y};
}
DI float silu(float g) { return g / (1.f + __expf(-g)); }
DI f32x4 mfma16(bf16x8 a, bf16x8 b, f32x4 c) { return __builtin_amdgcn_mfma_f32_16x16x32_bf16(a, b, c, 0, 0, 0); }


#define XB_TMO      128
#define XB_XCNT(j)  (256  + 64 * (j))
#define XB_XSUB(j)  (1280 + 64 * (j))
#define XB_XGEN(j)  (2304 + 64 * (j))
#define XB_TOP      3328
#define XB_TOPGEN   3392
#define XCD_BAR_WORDS 3456
#define XB_SPIN_CAP (1u << 18)
DI unsigned xb_ld(unsigned* p)              { return __hip_atomic_load(p, __ATOMIC_RELAXED, __HIP_MEMORY_SCOPE_AGENT); }
DI unsigned xb_add(unsigned* p, unsigned v) { return __hip_atomic_fetch_add(p, v, __ATOMIC_RELAXED, __HIP_MEMORY_SCOPE_AGENT); }
DI unsigned xb_xcc_id() { return (unsigned)__builtin_amdgcn_s_getreg((3 << 11) | 20) & 0xFu; }
#define XB_SPIN(cond, bar) do { unsigned _sp = 0; while (cond) { __builtin_amdgcn_s_sleep(1); \
    if ((++_sp & 255u) == 0u) { if (xb_ld(&(bar)[XB_TMO])) break; if (_sp > XB_SPIN_CAP) { atomicAdd(&(bar)[XB_TMO], 1u); break; } } } } while (0)
struct XcdBarrier { unsigned* bar; unsigned x; volatile LAS unsigned* st; };
DI XcdBarrier xcd_barrier_post(unsigned* bar, volatile LAS unsigned* st) {
    XcdBarrier b; b.bar = bar; b.x = xb_xcc_id(); b.st = st;
    if (threadIdx.x == 0) (void)xb_add(&bar[XB_XCNT(b.x)], 1u);
    return b;
}
DI void xcd_barrier_complete(unsigned* bar, unsigned x, unsigned& nloc, unsigned& nx) {
    const unsigned G = gridDim.x * gridDim.y * gridDim.z;
    unsigned sum, cnt, mine, sp = 0u;
    for (;;) {
        sum = 0u; cnt = 0u; mine = 0u;
#pragma unroll
        for (unsigned j = 0; j < 16; ++j) { const unsigned c = xb_ld(&bar[XB_XCNT(j)]); sum += c; cnt += (c > 0u) ? 1u : 0u; mine = (j == x) ? c : mine; }
        if (sum == G) break;
        __builtin_amdgcn_s_sleep(1);
        if ((++sp & 255u) == 0u) { if (xb_ld(&bar[XB_TMO])) break; if (sp > XB_SPIN_CAP) { atomicAdd(&bar[XB_TMO], 1u); break; } }
    }
    nloc = mine > 0u ? mine : 1u; nx = cnt > 0u ? cnt : 1u;
}
DI void xcd_barrier(const XcdBarrier& b) {
    asm volatile("s_waitcnt vmcnt(0)" ::: "memory");
    __syncthreads();
    if (threadIdx.x == 0) {
        unsigned* bar = b.bar;
        __builtin_amdgcn_s_waitcnt(0);
        unsigned nloc = b.st[0], nx = b.st[1];
        if (nloc == 0u) { xcd_barrier_complete(bar, b.x, nloc, nx); b.st[0] = nloc; b.st[1] = nx; }
        const unsigned old = xb_add(&bar[XB_XSUB(b.x)], 1u);
        const unsigned gen = old / nloc;
        if (old + 1u == (gen + 1u) * nloc) {
            __builtin_amdgcn_fence(__ATOMIC_RELEASE, "agent");
            asm volatile("s_waitcnt vmcnt(0)" ::: "memory");
            const unsigned og = xb_add(&bar[XB_TOP], 1u);
            const unsigned tg = og / nx;
            if (og + 1u == (tg + 1u) * nx) xb_add(&bar[XB_TOPGEN], 1u);
            else XB_SPIN(xb_ld(&bar[XB_TOPGEN]) == tg, bar);
            __builtin_amdgcn_fence(__ATOMIC_ACQUIRE, "agent");
            xb_add(&bar[XB_XGEN(b.x)], 1u);
            asm volatile("s_waitcnt vmcnt(0)" ::: "memory");
        } else {
            XB_SPIN(xb_ld(&bar[XB_XGEN(b.x)]) == gen, bar);
            __builtin_amdgcn_fence(__ATOMIC_ACQUIRE, "agent");
            asm volatile("s_waitcnt vmcnt(0)" ::: "memory");
        }
    }
    __syncthreads();
}

namespace pg8 {
constexpr int BM = 256, BK = 64, HALF = 128, HTB = HALF * BK * 2, STAGE_BYTES = 8 * HTB, NXCD = 8, WGM = 8;
DI int lds_byte(int r, int c) { const int st = (r >> 4) * 2 + (c >> 5), rr = r & 15, cc = c & 31, ob = rr * 64 + cc * 2; return st * 1024 + (ob ^ (((ob >> 9) & 1) << 5)); }
DI void stage_rc(int b, int& R, int& C) { const int st = b / 1024, sb = b % 1024, swz = sb ^ (((sb >> 9) & 1) << 5); R = (st >> 1) * 16 + swz / 64; C = (st & 1) * 32 + (swz % 64) / 2; }
DI int perm32(int rho) { const int n = rho >> 4, i = rho & 15; return 8 * (i >> 2) + 4 * n + (i & 3); }
struct Unit { int pm, pn; };
struct Gemm { const bf16_t* A; const bf16_t* Bt; int M, N, K, lda; };
struct StaticOrder {
    int nM, nN, nwg, G, c;
    DI void init(int M, int N, int G_, int c_) { nM = M / BM; nN = N / BM; nwg = nM * nN; G = G_; c = c_; }
    DI bool next(int i, Unit& u) const {
        const long L = (long)i * G + c; if (L >= nwg) return false;
        int wgid = (int)L; { const int q = nwg / NXCD, r = nwg % NXCD, xcd = wgid % NXCD, off = wgid / NXCD; wgid = (xcd < r ? xcd * (q + 1) : r * (q + 1) + (xcd - r) * q) + off; }
        const int nig = WGM * nN, gid = wgid / nig, fm = gid * WGM, gsz = (nM - fm) < WGM ? (nM - fm) : WGM;
        u.pm = fm + ((wgid % nig) % gsz); u.pn = (wgid % nig) / gsz; return true;
    }
};
struct Epi {
    int mode; bf16_t* O; int ldc;
    const float* ssq_in;
    bf16_t* X;
    float* C;
    float* ssq_out;
    DI void operator()(const f32x4 (&acc)[2][2][4][2], const Unit& u, int wr, int wc, int fr, int fq, LAS unsigned char* lds) const {
        if (mode == 0) {
            const int row0 = u.pm * BM + wr * 64 + fr, col0 = u.pn * BM + wc * 32 + 8 * fq;
            float rs[2][4];
#pragma unroll
            for (int ai = 0; ai < 2; ++ai)
#pragma unroll
                for (int m = 0; m < 4; ++m) rs[ai][m] = 1.f;
            if (ssq_in) {
                f32x4 pp[2][4];
#pragma unroll
                for (int ai = 0; ai < 2; ++ai)
#pragma unroll
                    for (int m = 0; m < 4; ++m) pp[ai][m] = *(const LAS f32x4*)(lds + SSQ_LDS_OFF + (wr * 64 + fr + ai * HALF + m * 16) * 64 + fq * 16);
#pragma unroll
                for (int ai = 0; ai < 2; ++ai)
#pragma unroll
                    for (int m = 0; m < 4; ++m) { float s = (pp[ai][m][0] + pp[ai][m][1]) + (pp[ai][m][2] + pp[ai][m][3]); s += __shfl_xor(s, 16); s += __shfl_xor(s, 32); rs[ai][m] = rsqrtf(s * (1.f / DM) + EPS); }
            }
            const __amdgpu_buffer_rsrc_t orsrc = __builtin_amdgcn_make_buffer_rsrc((void*)O, (short)0, 0x7fffffff, 0x00020000);
#pragma unroll
            for (int ai = 0; ai < 2; ++ai)
#pragma unroll
                for (int m = 0; m < 4; ++m) { const unsigned ro = (unsigned)(((size_t)(row0 + ai * HALF + m * 16) * ldc + col0) * 2);
#pragma unroll
                    for (int bj = 0; bj < 2; ++bj) { const f32x4 v0 = acc[ai][bj][m][0] * rs[ai][m], v1 = acc[ai][bj][m][1] * rs[ai][m];
                        u32x4 w; w.x = pk2(v0[0], v0[1]); w.y = pk2(v0[2], v0[3]); w.z = pk2(v1[0], v1[1]); w.w = pk2(v1[2], v1[3]);
                        __builtin_amdgcn_raw_buffer_store_b128(w, orsrc, ro + bj * HALF * 2, 0, 16); } }
        } else {
            const int row0 = u.pm * BM + wr * 64 + fr, col0 = u.pn * BM + wc * 32 + 8 * fq;
#pragma unroll
            for (int ai = 0; ai < 2; ++ai) {
                u32x4 rb[4][2];
#pragma unroll
                for (int m = 0; m < 4; ++m)
#pragma unroll
                    for (int bj = 0; bj < 2; ++bj) rb[m][bj] = *(const u32x4*)(X + (size_t)(row0 + ai * HALF + m * 16) * DM + col0 + bj * HALF);
#pragma unroll
                for (int m = 0; m < 4; ++m) {
                    const size_t ro = (size_t)(row0 + ai * HALF + m * 16) * DM + col0;
                    float ssp = 0.f;
#pragma unroll
                    for (int bj = 0; bj < 2; ++bj) { const u32x4 r = rb[m][bj];
                        f32x4 v0 = acc[ai][bj][m][0], v1 = acc[ai][bj][m][1];
                        v0[0] += bflo(r.x); v0[1] += bfhi(r.x); v0[2] += bflo(r.y); v0[3] += bfhi(r.y); v1[0] += bflo(r.z); v1[1] += bfhi(r.z); v1[2] += bflo(r.w); v1[3] += bfhi(r.w);
                        if (C) { *(f32x4*)(C + ro + bj * HALF) = v0; *(f32x4*)(C + ro + bj * HALF + 4) = v1; }
                        else { u32x4 w; w.x = pk2(v0[0], v0[1]); w.y = pk2(v0[2], v0[3]); w.z = pk2(v1[0], v1[1]); w.w = pk2(v1[2], v1[3]); *(u32x4*)(X + ro + bj * HALF) = w;
                            const float b0 = bflo(w.x), b1 = bfhi(w.x), b2 = bflo(w.y), b3 = bfhi(w.y), b4 = bflo(w.z), b5 = bfhi(w.z), b6 = bflo(w.w), b7 = bfhi(w.w);
                            ssp += ((b0 * b0 + b1 * b1) + (b2 * b2 + b3 * b3)) + ((b4 * b4 + b5 * b5) + (b6 * b6 + b7 * b7)); } }
                    if (!C) { ssp += __shfl_xor(ssp, 16); ssp += __shfl_xor(ssp, 32);
                        if (fq == 0) ssq_out[(size_t)(row0 + ai * HALF + m * 16) * 16 + u.pn * 4 + wc] = ssp; }
                }
            }
        }
    }
};

DI void gemm_phase(LAS unsigned char* lds, const Gemm g, const StaticOrder& S, const Epi& E) {
    const int tid = launder_tid(), wid = __builtin_amdgcn_readfirstlane(tid >> 6), lane = tid & 63, wr = wid >> 2, wc = wid & 3, fr = lane & 15, fq = lane >> 4;
    const int K = g.K, nt = K / BK, lda = g.lda;
    unsigned voffA[2], voffB[2];
#pragma unroll
    for (int i = 0; i < 2; ++i) { int R, C; stage_rc(tid * 16 + i * 8192, R, C); const int Rb = (R & ~31) + perm32(R & 31);
        voffA[i] = (unsigned)(R * lda + C) * 2u; voffB[i] = (unsigned)(Rb * K + C) * 2u; }
    const size_t kstep = (size_t)(BK * 2);
    const size_t hstepA = (size_t)HALF * lda * 2, hstepB = (size_t)HALF * K * 2;
    const size_t tstepA = 2 * hstepA, tstepB = 2 * hstepB;
    const unsigned ldsw = (unsigned)wid * 1024u;
    const int aoff = lds_byte(wr * 64 + fr, fq * 8), boff = lds_byte(wc * 32 + fr, fq * 8);
#define PG8_SA(b, h) (((b) * 2 + (h)) * HTB)
#define PG8_SB(b, h) ((4 + (b) * 2 + (h)) * HTB)
#define PG8_STAGE(bufoff, gbase, voff) do { _Pragma("unroll") for (int _i = 0; _i < 2; ++_i) \
        __builtin_amdgcn_global_load_lds((const unsigned*)((const char*)(gbase) + (voff)[_i]), (LAS unsigned*)(lds + (bufoff) + ldsw + _i * 8192), 16, 0, 0); } while (0)
#define PG8_LDA(dst, b, h) do { _Pragma("unroll") for (int m = 0; m < 4; ++m) _Pragma("unroll") for (int k = 0; k < 2; ++k) dst[m][k] = *(const LAS bf16x8*)(lds + PG8_SA(b, h) + aoff + m * 2048 + k * 1024); } while (0)
#define PG8_LDB(dst, b, h) do { _Pragma("unroll") for (int n = 0; n < 2; ++n) _Pragma("unroll") for (int k = 0; k < 2; ++k) dst[n][k] = *(const LAS bf16x8*)(lds + PG8_SB(b, h) + boff + n * 2048 + k * 1024); } while (0)
#define PG8_MMA(ai, bj, At, Bt) do { __builtin_amdgcn_s_setprio(1); _Pragma("unroll") for (int m = 0; m < 4; ++m) _Pragma("unroll") for (int n = 0; n < 2; ++n) _Pragma("unroll") for (int k = 0; k < 2; ++k) \
        acc[ai][bj][m][n] = __builtin_amdgcn_mfma_f32_16x16x32_bf16(Bt[n][k], At[m][k], acc[ai][bj][m][n], 0, 0, 0); __builtin_amdgcn_s_setprio(0); } while (0)
#define PG8_WAIT_V(n) asm volatile("s_waitcnt vmcnt(" #n ")" ::: "memory")
#define PG8_WAIT_L(n) asm volatile("s_waitcnt lgkmcnt(" #n ")" ::: "memory")
#define PG8_BAR __builtin_amdgcn_s_barrier()
#define PG8_SCHED __builtin_amdgcn_sched_barrier(0)
    Unit cur, nxt; int ui = 0;
    if (!S.next(0, cur)) return;
    f32x4 acc[2][2][4][2];
#pragma unroll
    for (int a = 0; a < 2; ++a)
#pragma unroll
        for (int b = 0; b < 2; ++b)
#pragma unroll
            for (int m = 0; m < 4; ++m)
#pragma unroll
                for (int n = 0; n < 2; ++n) acc[a][b][m][n] = (f32x4){0.f, 0.f, 0.f, 0.f};
    bf16x8 At[4][2], B0[2][2], B1[2][2];
    const char* cA = (const char*)g.A + (size_t)cur.pm * tstepA; const char* cB = (const char*)g.Bt + (size_t)cur.pn * tstepB;
    PG8_STAGE(PG8_SB(0, 0), cB, voffB); PG8_STAGE(PG8_SB(0, 1), cB + hstepB, voffB); PG8_STAGE(PG8_SA(0, 0), cA, voffA); PG8_STAGE(PG8_SA(0, 1), cA + hstepA, voffA);
    if (wr == 1) PG8_BAR;
    PG8_WAIT_V(2); PG8_BAR;
    PG8_STAGE(PG8_SB(1, 0), cB + kstep, voffB); PG8_STAGE(PG8_SA(1, 0), cA + kstep, voffA); PG8_STAGE(PG8_SB(1, 1), cB + hstepB + kstep, voffB);
    PG8_WAIT_V(6); PG8_BAR;
    for (;;) {
        const bool has_next = S.next(ui + 1, nxt);
        const char* nA = has_next ? (const char*)g.A + (size_t)nxt.pm * tstepA : cA; const char* nB = has_next ? (const char*)g.Bt + (size_t)nxt.pn * tstepB : cB;
        for (int t = 0; t < nt; t += 2) {
            const bool last = (t == nt - 2);
            const char* a1 = cA + (size_t)(t + 1) * kstep;
            const char* a2 = last ? nA : cA + (size_t)(t + 2) * kstep; const char* b2 = last ? nB : cB + (size_t)(t + 2) * kstep;
            const char* a3 = a2 + kstep; const char* b3 = b2 + kstep;
            if (last && E.ssq_in) {
                const char* sp = (const char*)(E.ssq_in + (size_t)cur.pm * BM * 16) + (size_t)wid * 2048 + (size_t)lane * 16;
                __builtin_amdgcn_global_load_lds((const unsigned*)sp, (LAS unsigned*)(lds + SSQ_LDS_OFF + wid * 2048), 16, 0, 0);
                __builtin_amdgcn_global_load_lds((const unsigned*)(sp + 1024), (LAS unsigned*)(lds + SSQ_LDS_OFF + wid * 2048 + 1024), 16, 0, 0);
                __builtin_amdgcn_sched_barrier(0);
            }
            PG8_LDB(B0, 0, 0); PG8_LDB(B1, 0, 1); PG8_SCHED; PG8_LDA(At, 0, 0); PG8_STAGE(PG8_SA(1, 1), a1 + hstepA, voffA);
            PG8_WAIT_V(8); PG8_WAIT_L(0); PG8_BAR; PG8_MMA(0, 0, At, B0); PG8_MMA(0, 1, At, B1); PG8_BAR; PG8_SCHED;
            PG8_LDA(At, 0, 1); PG8_STAGE(PG8_SB(0, 0), b2, voffB); PG8_STAGE(PG8_SB(0, 1), b2 + hstepB, voffB); PG8_STAGE(PG8_SA(0, 0), a2, voffA);
            PG8_WAIT_V(8); PG8_WAIT_L(0); PG8_BAR; PG8_MMA(1, 0, At, B0); PG8_MMA(1, 1, At, B1); PG8_BAR; PG8_SCHED;
            PG8_LDB(B0, 1, 0); PG8_LDB(B1, 1, 1); PG8_SCHED; PG8_LDA(At, 1, 0); PG8_STAGE(PG8_SA(0, 1), a2 + hstepA, voffA);
            PG8_WAIT_V(8); PG8_WAIT_L(0); PG8_BAR; PG8_MMA(0, 0, At, B0); PG8_MMA(0, 1, At, B1); PG8_BAR; PG8_SCHED;
            PG8_LDA(At, 1, 1); PG8_STAGE(PG8_SB(1, 0), b3, voffB); PG8_STAGE(PG8_SB(1, 1), b3 + hstepB, voffB); PG8_STAGE(PG8_SA(1, 0), a3, voffA);
            PG8_WAIT_V(8); PG8_WAIT_L(0); PG8_BAR; PG8_MMA(1, 0, At, B0); PG8_MMA(1, 1, At, B1); PG8_BAR; PG8_SCHED;
        }
        if (wr == 0) PG8_BAR;
        E(acc, cur, wr, wc, fr, fq, lds);
        if (!has_next) break;
#pragma unroll
        for (int a = 0; a < 2; ++a)
#pragma unroll
            for (int b = 0; b < 2; ++b)
#pragma unroll
                for (int m = 0; m < 4; ++m)
#pragma unroll
                    for (int n = 0; n < 2; ++n) acc[a][b][m][n] = (f32x4){0.f, 0.f, 0.f, 0.f};
        cur = nxt; cA = nA; cB = nB; ++ui;
        if (wr == 1) PG8_BAR;
    }
    PG8_WAIT_V(0);
    PG8_BAR;
#undef PG8_SA
#undef PG8_SB
#undef PG8_STAGE
#undef PG8_LDA
#undef PG8_LDB
#undef PG8_MMA
#undef PG8_WAIT_V
#undef PG8_WAIT_L
#undef PG8_BAR
#undef PG8_SCHED
}
}

DI void convert_wT(LAS unsigned char* lds, const float* W, const float* gain, bf16_t* Wt, int K, int N, int bid, int nb) {
    LAS bf16_t* tile = (LAS bf16_t*)lds;
    const int tid = launder_tid();
    const int ntn = N / 64, ntiles = (K / 64) * ntn;
    const int kk = tid >> 3, c8 = (tid & 7) * 8;
    f32x4 a, b; float g = 1.f;
    if (bid < ntiles) { const int k0 = (bid / ntn) * 64, n0 = (bid % ntn) * 64; const float* src = W + (size_t)(k0 + kk) * N + n0 + c8; a = *(const f32x4*)src; b = *(const f32x4*)(src + 4); g = gain ? gain[k0 + kk] : 1.f; }
    for (int t = bid; t < ntiles; t += nb) {
        const int k0 = (t / ntn) * 64, n0 = (t % ntn) * 64;
        const f32x4 ca = a, cb = b; const float cg = g;
        if (t + nb < ntiles) { const int k1 = ((t + nb) / ntn) * 64, n1 = ((t + nb) % ntn) * 64; const float* src = W + (size_t)(k1 + kk) * N + n1 + c8; a = *(const f32x4*)src; b = *(const f32x4*)(src + 4); g = gain ? gain[k1 + kk] : 1.f; }
        __syncthreads();
        tile[(c8 + 0) * 72 + kk] = f2bf(ca[0] * cg); tile[(c8 + 1) * 72 + kk] = f2bf(ca[1] * cg);
        tile[(c8 + 2) * 72 + kk] = f2bf(ca[2] * cg); tile[(c8 + 3) * 72 + kk] = f2bf(ca[3] * cg);
        tile[(c8 + 4) * 72 + kk] = f2bf(cb[0] * cg); tile[(c8 + 5) * 72 + kk] = f2bf(cb[1] * cg);
        tile[(c8 + 6) * 72 + kk] = f2bf(cb[2] * cg); tile[(c8 + 7) * 72 + kk] = f2bf(cb[3] * cg);
        __syncthreads();
        const int n = tid >> 3, k8 = (tid & 7) * 8;
        const u32x4 v = *(LAS u32x4*)(tile + n * 72 + k8);
        *(u32x4*)(Wt + (size_t)(n0 + n) * K + k0 + k8) = v;
    }
    __syncthreads();
}

DI void norm_rows(const float* x, bf16_t* xn, int nrows, int bid, int nb) {
    const int tid_ = launder_tid(); const int wave = tid_ >> 6, lane = tid_ & 63;
    for (int row0 = (bid * 8 + wave) * 4; row0 < nrows; row0 += nb * 32) {
        f32x4 v[4][4];
#pragma unroll
        for (int r = 0; r < 4; ++r) { const f32x4* src = (const f32x4*)(x + (size_t)(row0 + r) * DM);
#pragma unroll
            for (int i = 0; i < 4; ++i) v[r][i] = src[lane + 64 * i]; }
#pragma unroll
        for (int r = 0; r < 4; ++r) {
            float ss = 0.f;
#pragma unroll
            for (int i = 0; i < 4; ++i) ss += v[r][i][0] * v[r][i][0] + v[r][i][1] * v[r][i][1] + v[r][i][2] * v[r][i][2] + v[r][i][3] * v[r][i][3];
#pragma unroll
            for (int o = 32; o >= 1; o >>= 1) ss += __shfl_xor(ss, o);
            const float rstd = rsqrtf(ss * (1.f / DM) + EPS);
#pragma unroll
            for (int i = 0; i < 4; ++i) { u32x2 w; w.x = pk2(v[r][i][0] * rstd, v[r][i][1] * rstd); w.y = pk2(v[r][i][2] * rstd, v[r][i][3] * rstd);
                *(u32x2*)(xn + (size_t)(row0 + r) * DM + (lane + 64 * i) * 4) = w; }
        }
    }
}

DI void prep_rows(const float* x, bf16_t* xn, float* ssq, int nrows, int bid, int nb) {
    const int tid_ = launder_tid(); const int wave = tid_ >> 6, lane = tid_ & 63;
    for (int row0 = (bid * 8 + wave) * 4; row0 < nrows; row0 += nb * 32) {
        f32x4 v[4][4];
#pragma unroll
        for (int r = 0; r < 4; ++r) { const f32x4* src = (const f32x4*)(x + (size_t)(row0 + r) * DM);
#pragma unroll
            for (int i = 0; i < 4; ++i) v[r][i] = src[lane + 64 * i]; }
#pragma unroll
        for (int r = 0; r < 4; ++r) {
            float ss = 0.f;
#pragma unroll
            for (int i = 0; i < 4; ++i) { u32x2 w; w.x = pk2(v[r][i][0], v[r][i][1]); w.y = pk2(v[r][i][2], v[r][i][3]);
                *(u32x2*)(xn + (size_t)(row0 + r) * DM + (lane + 64 * i) * 4) = w;
                const float b0 = bflo(w.x), b1 = bfhi(w.x), b2 = bflo(w.y), b3 = bfhi(w.y); ss += (b0 * b0 + b1 * b1) + (b2 * b2 + b3 * b3); }
#pragma unroll
            for (int o = 32; o >= 1; o >>= 1) ss += __shfl_xor(ss, o);
            if (lane < 16) ssq[(size_t)(row0 + r) * 16 + lane] = (lane == 0) ? ss : 0.f;
        }
    }
}

constexpr int KVS = 272;
template <int NT, bool DIL>
DI void attn_core(LAS unsigned char* Kl, LAS unsigned char* Vl, const bf16x8 (&qf)[4], int k0, int qi, bool noprev, int flip, f32x4 (&o)[8], float& m_out, float& l_out) {
    const int lane = launder_tid() & 63, l15 = lane & 15, quad = lane >> 4;
    f32x4 s[NT];
#pragma unroll
    for (int kt = 0; kt < NT; ++kt) {
        s[kt] = (f32x4){0.f, 0.f, 0.f, 0.f};
        LAS unsigned char* kp = Kl + ((k0 + 16 * kt + l15) ^ flip) * KVS + quad * 16;
#pragma unroll
        for (int ks = 0; ks < 4; ++ks) { const bf16x8 kf = *(const LAS bf16x8*)(kp + ks * 64); s[kt] = mfma16(kf, qf[ks], s[kt]); }
    }
    float m = -INFINITY;
#pragma unroll
    for (int kt = 0; kt < NT; ++kt)
#pragma unroll
        for (int r = 0; r < 4; ++r) {
            if (DIL) {
                const int j = k0 + 16 * kt + 4 * quad + r; bool valid = true;
                if (kt == 0) valid = valid && (j >= qi);
                if (kt == NT - 1) valid = valid && (j <= qi + 128);
                if (noprev) valid = valid && (j >= 128);
                if (kt == 0 || kt == NT - 1 || noprev) s[kt][r] = valid ? s[kt][r] : -INFINITY; }
            m = fmaxf(m, s[kt][r]);
        }
    m = fmaxf(m, __shfl_xor(m, 16)); m = fmaxf(m, __shfl_xor(m, 32));
    float l = 0.f;
#pragma unroll
    for (int kt = 0; kt < NT; ++kt)
#pragma unroll
        for (int r = 0; r < 4; ++r) { const float p = __builtin_amdgcn_exp2f(s[kt][r] - m); l += p; s[kt][r] = p; }
    l += __shfl_xor(l, 16); l += __shfl_xor(l, 32);
#pragma unroll
    for (int dt = 0; dt < 8; ++dt) o[dt] = (f32x4){0.f, 0.f, 0.f, 0.f};
    constexpr int NP = (NT + 1) / 2;
#pragma unroll
    for (int pp = 0; pp < NP; ++pp) {
        u32x4 pw; pw.x = pk2(s[2 * pp][0], s[2 * pp][1]); pw.y = pk2(s[2 * pp][2], s[2 * pp][3]);
        if (2 * pp + 1 < NT) { pw.z = pk2(s[(2 * pp + 1 < NT) ? 2 * pp + 1 : 0][0], s[(2 * pp + 1 < NT) ? 2 * pp + 1 : 0][1]); pw.w = pk2(s[(2 * pp + 1 < NT) ? 2 * pp + 1 : 0][2], s[(2 * pp + 1 < NT) ? 2 * pp + 1 : 0][3]); }
        else { pw.z = 0u; pw.w = 0u; }
        const bf16x8 pf = __builtin_bit_cast(bf16x8, pw);
        LAS unsigned char* vlo = Vl + ((k0 + 32 * pp + 4 * quad + (l15 >> 2)) ^ flip) * KVS + (l15 & 3) * 8;
        LAS unsigned char* vhi = (2 * pp + 1 < NT) ? Vl + ((k0 + 32 * pp + 16 + 4 * quad + (l15 >> 2)) ^ flip) * KVS + (l15 & 3) * 8 : vlo;
#pragma unroll
        for (int dt = 0; dt < 8; ++dt) {
            const s16x4 lo = __builtin_amdgcn_ds_read_tr16_b64_v4i16((LAS s16x4*)(vlo + dt * 32));
            const s16x4 hi = __builtin_amdgcn_ds_read_tr16_b64_v4i16((LAS s16x4*)(vhi + dt * 32));
            const bf16x8 vf = __builtin_shufflevector(lo, hi, 0, 1, 2, 3, 4, 5, 6, 7);
            o[dt] = mfma16(vf, pf, o[dt]);
        }
    }
    m_out = m; l_out = l;
}

DI void rot_cs(int pos, double f2pi, float& cs, float& sn) {
    const double rev = (double)pos * f2pi; const float fr = (float)(rev - __builtin_floor(rev));
    cs = __builtin_amdgcn_cosf(fr); sn = __builtin_amdgcn_sinf(fr);
}
#define ROTF(i) ((i) == 0 ? 0.15915494309189535 : (i) == 1 ? 0.0700865215877985 : (i) == 2 ? 0.03086376340470123 : (i) == 3 ? 0.013591370636193905 : \
                 (i) == 4 ? 0.005985185712713705 : (i) == 5 ? 0.002635675898667414 : (i) == 6 ? 0.001160663641240061 : (i) == 7 ? 0.0005111175045375439 : \
                 (i) == 8 ? 0.00022507907903927653 : (i) == 9 ? 9.911730936901935e-05 : (i) == 10 ? 4.364795279280289e-05 : (i) == 11 ? 1.9221100684944863e-05 : \
                 (i) == 12 ? 8.464330808241401e-06 : (i) == 13 ? 3.727408601915352e-06 : (i) == 14 ? 1.6414262627950345e-06 : 7.228293068832865e-07)

__device__ const double kRotF[16] = {0.15915494309189535, 0.0700865215877985, 0.03086376340470123, 0.013591370636193905, 0.005985185712713705, 0.002635675898667414, 0.001160663641240061, 0.0005111175045375439,
                                     0.00022507907903927653, 9.911730936901935e-05, 4.364795279280289e-05, 1.9221100684944863e-05, 8.464330808241401e-06, 3.727408601915352e-06, 1.6414262627950345e-06, 7.228293068832865e-07};
DI void dil_chain(LAS unsigned char* lds, bf16_t* cols, float* lse, const float* rot, const float* qgain, const float* kgain, int w, int grp) {
    const int tid = launder_tid(), lane = tid & 63, wave = tid >> 6, l15 = lane & 15, quad = lane >> 4;
    int g, bl, h, r, c0, nblk;
    if (w < 256)      { g = 0; bl = w >> 5; h = (w >> 2) & 7; r = 0; c0 = (w & 3) * 4; nblk = 4; }
    else if (w < 512) { const int q = w - 256; g = 1; bl = q >> 5; h = (q >> 2) & 7; r = q & 3; c0 = 0; nblk = 4; }
    else              { const int q = w - 512; g = 2; bl = q >> 7; h = (q >> 4) & 7; r = q & 15; c0 = 0; nblk = 1; }
    const int d = 1 << (2 * g);
    const int bglob = grp * 8 + bl;
    const int qoff = g * 1024 + h * 128, koff = 3072 + qoff, voff = 6144 + qoff;
    LAS unsigned char* Kl = lds; LAS unsigned char* Vl = lds + 256 * KVS;
    const GAS float* qg = launder_g(qgain + g * 128); const GAS float* kg = launder_g(kgain + g * 128); const GAS float* rotg = launder_g(rot);
    const bf16_t* bbase = cols + (size_t)bl * SEQ * IN_A;
    const int srow = tid >> 2, sq = tid & 3;
    const int i0 = wave * 16, qi = i0 + l15;
    u32x4 kr[4], vr[4], qr[4];
#define DIL_LOAD(cc) do { const int p_ = ((cc) * 128 + srow) * d + r; const bf16_t* rp_ = bbase + (size_t)p_ * IN_A; \
        _Pragma("unroll") for (int e_ = 0; e_ < 4; ++e_) { kr[e_] = *(const u32x4*)(rp_ + koff + sq * 32 + e_ * 8); vr[e_] = *(const u32x4*)(rp_ + voff + sq * 32 + e_ * 8); } } while (0)
#define DIL_LOADQ(cc) do { const int p_ = ((cc) * 128 + qi) * d + r; const bf16_t* rp_ = bbase + (size_t)p_ * IN_A + qoff; \
        _Pragma("unroll") for (int ks_ = 0; ks_ < 4; ++ks_) qr[ks_] = *(const u32x4*)(rp_ + ks_ * 32 + quad * 8); } while (0)
#define DIL_STAGE(cc) do { const int row_ = ((cc) & 1) * 128 + srow; LAS unsigned char* dK_ = Kl + row_ * KVS + sq * 64; LAS unsigned char* dV_ = Vl + row_ * KVS + sq * 64; \
        _Pragma("unroll") for (int e_ = 0; e_ < 4; ++e_) *(LAS u32x4*)(dV_ + e_ * 16) = vr[e_]; \
        float kf_[32]; float ss_ = 0.f; \
        _Pragma("unroll") for (int e_ = 0; e_ < 4; ++e_) _Pragma("unroll") for (int w_ = 0; w_ < 4; ++w_) { kf_[e_ * 8 + 2 * w_] = bflo(kr[e_][w_]); kf_[e_ * 8 + 2 * w_ + 1] = bfhi(kr[e_][w_]); } \
        _Pragma("unroll") for (int e_ = 0; e_ < 32; ++e_) ss_ += kf_[e_] * kf_[e_]; \
        ss_ += __shfl_xor(ss_, 1); ss_ += __shfl_xor(ss_, 2); \
        const float rstd_ = rsqrtf(ss_ * (1.f / 128.f) + EPS); \
        const GAS f32x4* gp_ = (const GAS f32x4*)(kg + sq * 32); \
        _Pragma("unroll") for (int e_ = 0; e_ < 8; ++e_) { const f32x4 gv_ = gp_[e_]; kf_[4 * e_] *= rstd_ * gv_[0]; kf_[4 * e_ + 1] *= rstd_ * gv_[1]; kf_[4 * e_ + 2] *= rstd_ * gv_[2]; kf_[4 * e_ + 3] *= rstd_ * gv_[3]; } \
        if (sq == 0) { const GAS f32x4* rt_ = (const GAS f32x4*)(rotg + (size_t)(bglob * SEQ + ((cc) * 128 + srow) * d + r) * 32); \
            _Pragma("unroll") for (int q4_ = 0; q4_ < 4; ++q4_) { const f32x4 cs4_ = rt_[q4_], sn4_ = rt_[4 + q4_]; \
                _Pragma("unroll") for (int u_ = 0; u_ < 4; ++u_) { const int q_ = 4 * q4_ + u_; const float x1_ = kf_[q_], x2_ = kf_[16 + q_]; kf_[q_] = x1_ * cs4_[u_] - x2_ * sn4_[u_]; kf_[16 + q_] = x2_ * cs4_[u_] + x1_ * sn4_[u_]; } } } \
        _Pragma("unroll") for (int e_ = 0; e_ < 4; ++e_) { u32x4 w_; w_.x = pk2(kf_[8 * e_], kf_[8 * e_ + 1]); w_.y = pk2(kf_[8 * e_ + 2], kf_[8 * e_ + 3]); w_.z = pk2(kf_[8 * e_ + 4], kf_[8 * e_ + 5]); w_.w = pk2(kf_[8 * e_ + 6], kf_[8 * e_ + 7]); \
            *(LAS u32x4*)(dK_ + e_ * 16) = w_; } } while (0)
    __syncthreads();
    if (c0 > 0) { DIL_LOAD(c0 - 1); DIL_STAGE(c0 - 1); }
    else { const int row_ = 128 + srow; const u32x4 z = (u32x4){0u, 0u, 0u, 0u};
#pragma unroll
        for (int e = 0; e < 4; ++e) { *(LAS u32x4*)(Kl + row_ * KVS + sq * 64 + e * 16) = z; *(LAS u32x4*)(Vl + row_ * KVS + sq * 64 + e * 16) = z; } }
    DIL_LOAD(c0); DIL_LOADQ(c0);
    for (int c = c0; c < c0 + nblk; ++c) {
        if (c > c0) __syncthreads();
        DIL_STAGE(c);
        const int p = (c * 128 + qi) * d + r;
        bf16_t* qrow = cols + (size_t)(bl * SEQ + p) * IN_A + qoff;
        bf16x8 qf[4];
        {
            float qv[4][8]; float ss = 0.f;
#pragma unroll
            for (int ks = 0; ks < 4; ++ks) { const u32x4 wq = qr[ks];
                qv[ks][0] = bflo(wq.x); qv[ks][1] = bfhi(wq.x); qv[ks][2] = bflo(wq.y); qv[ks][3] = bfhi(wq.y); qv[ks][4] = bflo(wq.z); qv[ks][5] = bfhi(wq.z); qv[ks][6] = bflo(wq.w); qv[ks][7] = bfhi(wq.w); }
#pragma unroll
            for (int ks = 0; ks < 4; ++ks)
#pragma unroll
                for (int e = 0; e < 8; ++e) ss += qv[ks][e] * qv[ks][e];
            ss += __shfl_xor(ss, 16); ss += __shfl_xor(ss, 32);
            const float rstd = rsqrtf(ss * (1.f / 128.f) + EPS) * QSCALE;
#pragma unroll
            for (int ks = 0; ks < 4; ++ks) { const f32x4 g0 = *(const GAS f32x4*)(qg + ks * 32 + quad * 8), g1 = *(const GAS f32x4*)(qg + ks * 32 + quad * 8 + 4);
                qv[ks][0] *= rstd * g0[0]; qv[ks][1] *= rstd * g0[1]; qv[ks][2] *= rstd * g0[2]; qv[ks][3] *= rstd * g0[3];
                qv[ks][4] *= rstd * g1[0]; qv[ks][5] *= rstd * g1[1]; qv[ks][6] *= rstd * g1[2]; qv[ks][7] *= rstd * g1[3]; }
            const GAS float* rt = rotg + (size_t)(bglob * SEQ + p) * 32 + (quad & 1) * 8;
            const f32x4 c0 = *(const GAS f32x4*)rt, c1 = *(const GAS f32x4*)(rt + 4), s0 = *(const GAS f32x4*)(rt + 16), s1 = *(const GAS f32x4*)(rt + 20);
            const bool second = quad >= 2;
#pragma unroll
            for (int e = 0; e < 8; ++e) {
                const float cs = e < 4 ? c0[e & 3] : c1[e & 3], sn = e < 4 ? s0[e & 3] : s1[e & 3];
                const float mine = qv[0][e], other = __shfl_xor(mine, 32);
                qv[0][e] = second ? (mine * cs + other * sn) : (mine * cs - other * sn);
            }
#pragma unroll
            for (int ks = 0; ks < 4; ++ks) { u32x4 wq; wq.x = pk2(qv[ks][0], qv[ks][1]); wq.y = pk2(qv[ks][2], qv[ks][3]); wq.z = pk2(qv[ks][4], qv[ks][5]); wq.w = pk2(qv[ks][6], qv[ks][7]); qf[ks] = __builtin_bit_cast(bf16x8, wq); }
        }
        if (c + 1 < c0 + nblk) { DIL_LOAD(c + 1); DIL_LOADQ(c + 1); }
        __syncthreads();
        f32x4 o[8]; float m, l;
        attn_core<9, true>(Kl, Vl, qf, i0, qi, c == 0, (c & 1) ? 0 : 128, o, m, l);
        const float inv = 1.f / l;
#pragma unroll
        for (int dt = 0; dt < 8; dt += 2) {
            u32x2 w0, w1; w0.x = pk2(o[dt][0] * inv, o[dt][1] * inv); w0.y = pk2(o[dt][2] * inv, o[dt][3] * inv); w1.x = pk2(o[dt + 1][0] * inv, o[dt + 1][1] * inv); w1.y = pk2(o[dt + 1][2] * inv, o[dt + 1][3] * inv);
            *(u32x4*)(qrow + (dt + (quad & 1)) * 16 + (quad >> 1) * 8) = swap16_pack(w0, w1); }
        if (quad == 0) lse[(size_t)(bl * SEQ + p) * 24 + g * 8 + h] = (m + __log2f(l)) * LN2;
    }
#undef DIL_LOAD
#undef DIL_LOADQ
#undef DIL_STAGE
}

DI void mem_attn_unit(LAS unsigned char* lds, bf16_t* cols, int ldc, int qmoff, int gmoff, const bf16_t* kvm, int lay, const float* qgain, const float* kgain, int unit, int bbase, int nq) {
    const int tid = launder_tid(), lane = tid & 63, wave = tid >> 6, l15 = lane & 15, quad = lane >> 4;
    const int nsub = 16 / nq, qsub = unit % nsub, bh = unit / nsub, h = bh & 3, bl = bh >> 2;
    const GAS float* qgg = launder_g(qgain); const GAS float* kgg = launder_g(kgain); const GAS bf16_t* kvmg = launder_g(kvm);
    const int bglob = bbase + bl;
    LAS unsigned char* Kl = lds; LAS unsigned char* Vl = lds + 256 * KVS;
    __syncthreads();
    {
        const int j = tid >> 1, half = tid & 1;
        LAS unsigned char* dK = Kl + j * KVS + half * 128; LAS unsigned char* dV = Vl + j * KVS + half * 128;
        const GAS bf16_t* rowp = kvmg + (size_t)(bglob * 256 + j) * 4096 + lay * 1024 + h * 128 + half * 64;
        const GAS u32x4* ks = (const GAS u32x4*)rowp; const GAS u32x4* vs = (const GAS u32x4*)(rowp + 512);
        u32x4 kr[8], vr[8];
#pragma unroll
        for (int e = 0; e < 8; ++e) { kr[e] = ks[e]; vr[e] = vs[e]; }
#pragma unroll
        for (int e = 0; e < 8; ++e) *(LAS u32x4*)(dV + e * 16) = vr[e];
        float ss = 0.f;
#pragma unroll
        for (int e = 0; e < 8; ++e)
#pragma unroll
            for (int w = 0; w < 4; ++w) { const float a = bflo(kr[e][w]), b = bfhi(kr[e][w]); ss += a * a + b * b; }
        ss += __shfl_xor(ss, 1);
        const float rstd = rsqrtf(ss * (1.f / 128.f) + EPS);
        const GAS f32x4* gp = (const GAS f32x4*)(kgg + half * 64);
#pragma unroll
        for (int e = 0; e < 8; ++e) {
            const f32x4 g0 = gp[2 * e], g1 = gp[2 * e + 1];
            u32x4 w;
            w.x = pk2(bflo(kr[e].x) * rstd * g0[0], bfhi(kr[e].x) * rstd * g0[1]); w.y = pk2(bflo(kr[e].y) * rstd * g0[2], bfhi(kr[e].y) * rstd * g0[3]);
            w.z = pk2(bflo(kr[e].z) * rstd * g1[0], bfhi(kr[e].z) * rstd * g1[1]); w.w = pk2(bflo(kr[e].w) * rstd * g1[2], bfhi(kr[e].w) * rstd * g1[3]);
            *(LAS u32x4*)(dK + e * 16) = w;
        }
    }
    u32x4 qr[4];
#define MEM_LOADQ(qt_) do { const bf16_t* qp_ = cols + (size_t)(bl * SEQ + (qt_) * 128 + wave * 16 + l15) * ldc + qmoff + h * 128; \
        _Pragma("unroll") for (int ks_ = 0; ks_ < 4; ++ks_) qr[ks_] = *(const u32x4*)(qp_ + ks_ * 32 + quad * 8); } while (0)
    MEM_LOADQ(qsub * nq);
    __syncthreads();
    for (int qq = 0; qq < nq; ++qq) {
        const int qt = qsub * nq + qq;
        const int p = qt * 128 + wave * 16 + l15;
        bf16_t* rowp = cols + (size_t)(bl * SEQ + p) * ldc;
        bf16x8 qf[4];
        {
            float qv[4][8]; float ss = 0.f;
#pragma unroll
            for (int ks = 0; ks < 4; ++ks) { const u32x4 w = qr[ks];
                qv[ks][0] = bflo(w.x); qv[ks][1] = bfhi(w.x); qv[ks][2] = bflo(w.y); qv[ks][3] = bfhi(w.y); qv[ks][4] = bflo(w.z); qv[ks][5] = bfhi(w.z); qv[ks][6] = bflo(w.w); qv[ks][7] = bfhi(w.w); }
#pragma unroll
            for (int ks = 0; ks < 4; ++ks)
#pragma unroll
                for (int e = 0; e < 8; ++e) ss += qv[ks][e] * qv[ks][e];
            ss += __shfl_xor(ss, 16); ss += __shfl_xor(ss, 32);
            const float rstd = rsqrtf(ss * (1.f / 128.f) + EPS) * QSCALE;
#pragma unroll
            for (int ks = 0; ks < 4; ++ks) { const f32x4 g0 = *(const GAS f32x4*)(qgg + ks * 32 + quad * 8), g1 = *(const GAS f32x4*)(qgg + ks * 32 + quad * 8 + 4);
                u32x4 w; w.x = pk2(qv[ks][0] * rstd * g0[0], qv[ks][1] * rstd * g0[1]); w.y = pk2(qv[ks][2] * rstd * g0[2], qv[ks][3] * rstd * g0[3]);
                w.z = pk2(qv[ks][4] * rstd * g1[0], qv[ks][5] * rstd * g1[1]); w.w = pk2(qv[ks][6] * rstd * g1[2], qv[ks][7] * rstd * g1[3]); qf[ks] = __builtin_bit_cast(bf16x8, w); }
        }
        if (qq + 1 < nq) MEM_LOADQ(qt + 1);
        bf16_t* grow = rowp + gmoff + h * 128;
        u32x4 gwv[4];
#pragma unroll
        for (int dp = 0; dp < 4; ++dp) gwv[dp] = *(const u32x4*)(grow + (2 * dp + (quad & 1)) * 16 + (quad >> 1) * 8);
        f32x4 o[8]; float m, l;
        attn_core<16, false>(Kl, Vl, qf, 0, 0, false, 0, o, m, l);
        const float inv = 1.f / l;
#pragma unroll
        for (int dp = 0; dp < 4; ++dp) {
            const int dt = 2 * dp;
            u32x2 w0, w1; w0.x = pk2(o[dt][0] * inv, o[dt][1] * inv); w0.y = pk2(o[dt][2] * inv, o[dt][3] * inv); w1.x = pk2(o[dt + 1][0] * inv, o[dt + 1][1] * inv); w1.y = pk2(o[dt + 1][2] * inv, o[dt + 1][3] * inv);
            const u32x4 ov = swap16_pack(w0, w1), gw = gwv[dp];
            u32x4 y;
#pragma unroll
            for (int e = 0; e < 4; ++e) y[e] = pk2(bflo(ov[e]) * silu(bflo(gw[e])), bfhi(ov[e]) * silu(bfhi(gw[e])));
            *(u32x4*)(grow + (dt + (quad & 1)) * 16 + (quad >> 1) * 8) = y;
        }
    }
#undef MEM_LOADQ
}

DI void gla_item(LAS unsigned char* lds, bf16_t* cols, const float* lb, int item) {
    const int tid = launder_tid(), lane = tid & 63, wave = tid >> 6, l15 = lane & 15, quad = lane >> 4;
    const int vh = item & 1, h = (item >> 1) & 7, b = item >> 4;
    LAS unsigned char* RQ = lds; LAS unsigned char* RF = RQ + 16384; LAS unsigned char* QT = RF + 16384; LAS unsigned char* KT = QT + 17408; LAS unsigned char* QG = KT + 17408;
    LAS unsigned char* KD = QG + 17408; LAS unsigned char* VT = KD + 18432; LAS unsigned char* AT = VT + 9216; LAS unsigned char* ST = AT + 9216; LAS unsigned char* GL = ST + 17408; LAS unsigned char* SEG = GL + 512;
    bf16_t* base = cols + (size_t)b * SEQ * IN_B;
    const int qcol = h * 128, fcol = 1024 + h * 128, vcol = 2048 + h * 128 + vh * 64;
    const int ek = tid & 127, eseg = tid >> 7;
    const GAS float* lbg = launder_g(lb);
    const float lbk = lbg[h * 128 + ek], omlb = 1.f - lbk;
    f32x4 sacc[4];
#pragma unroll
    for (int i = 0; i < 4; ++i) sacc[i] = (f32x4){0.f, 0.f, 0.f, 0.f};
    __syncthreads();
    for (int i = tid; i < 17408 / 16; i += NTHREADS) ((LAS u32x4*)ST)[i] = (u32x4){0u, 0u, 0u, 0u};
    const int lrow = tid >> 3, lc16 = tid & 7, vt_t = tid & 63, vt_v8 = tid >> 6;
    u32x4 pq0, pq1, pf0, pf1, pv;
#define GLA_LOAD(cc) do { const bf16_t* rp = base + (size_t)((cc) * 64 + lrow) * IN_B; \
        pq0 = *(const u32x4*)(rp + qcol + lc16 * 8); pq1 = *(const u32x4*)(rp + qcol + 64 + lc16 * 8); \
        pf0 = *(const u32x4*)(rp + fcol + lc16 * 8); pf1 = *(const u32x4*)(rp + fcol + 64 + lc16 * 8); \
        pv = *(const u32x4*)(base + (size_t)((cc) * 64 + vt_t) * IN_B + vcol + vt_v8 * 8); } while (0)
#define GLA_STORE() do { *(LAS u32x4*)(RQ + lrow * 256 + lc16 * 16) = pq0; *(LAS u32x4*)(RQ + lrow * 256 + 128 + lc16 * 16) = pq1; \
        *(LAS u32x4*)(RF + lrow * 256 + lc16 * 16) = pf0; *(LAS u32x4*)(RF + lrow * 256 + 128 + lc16 * 16) = pf1; \
        LAS bf16_t* vt = (LAS bf16_t*)VT + (vt_v8 * 8) * 72 + vt_t; \
        vt[0 * 72] = (bf16_t)(pv.x & 0xffffu); vt[1 * 72] = (bf16_t)(pv.x >> 16); vt[2 * 72] = (bf16_t)(pv.y & 0xffffu); vt[3 * 72] = (bf16_t)(pv.y >> 16); \
        vt[4 * 72] = (bf16_t)(pv.z & 0xffffu); vt[5 * 72] = (bf16_t)(pv.z >> 16); vt[6 * 72] = (bf16_t)(pv.w & 0xffffu); vt[7 * 72] = (bf16_t)(pv.w >> 16); } while (0)
    GLA_LOAD(0); GLA_STORE();
    for (int c = 0; c < 32; ++c) {
        __syncthreads();
        if (c + 1 < 32) GLA_LOAD(c + 1);
        float cp[16], kk[16], qq[16]; float run = 1.f;
#pragma unroll
        for (int tt = 0; tt < 16; ++tt) { const int t = eseg * 16 + tt;
            const float z = bf2f(((LAS bf16_t*)RF)[t * 128 + ek]);
            const float sg = __builtin_amdgcn_rcpf(1.f + __expf(-z)); const float fg = lbk + omlb * sg;
            run *= fg; cp[tt] = run; kk[tt] = 1.f - fg; qq[tt] = bf2f(((LAS bf16_t*)RQ)[t * 128 + ek]); }
        ((LAS float*)SEG)[eseg * 128 + ek] = run;
        __syncthreads();
        const float s0 = ((LAS float*)SEG)[ek], s1 = ((LAS float*)SEG)[128 + ek], s2 = ((LAS float*)SEG)[256 + ek], s3 = ((LAS float*)SEG)[384 + ek];
        const float pmid = s0 * s1, ptail = s2 * s3;
        const float e1s = (eseg == 0) ? __builtin_amdgcn_rcpf(s0) * __builtin_amdgcn_rcpf(s1) : (eseg == 1) ? __builtin_amdgcn_rcpf(s1) : (eseg == 2) ? 1.f : s2;
        if (eseg == 0) ((LAS float*)GL)[ek] = pmid * ptail;
        unsigned kdp[8];
#pragma unroll
        for (int tt = 0; tt < 16; tt += 2) {
            float kd2[2];
#pragma unroll
            for (int u = 0; u < 2; ++u) { const int t = eseg * 16 + tt + u;
                const float e1 = cp[tt + u] * e1s, r1 = __builtin_amdgcn_rcpf(e1);
                ((LAS bf16_t*)QG)[t * 136 + ek] = f2bf(qq[tt + u] * e1 * pmid);
                ((LAS bf16_t*)QT)[t * 136 + ek] = f2bf(qq[tt + u] * e1);
                ((LAS bf16_t*)KT)[t * 136 + ek] = f2bf(kk[tt + u] * r1);
                kd2[u] = kk[tt + u] * (ptail * r1); }
            kdp[tt >> 1] = pk2(kd2[0], kd2[1]);
        }
        *(LAS u32x4*)(KD + ek * 144 + eseg * 32) = (u32x4){kdp[0], kdp[1], kdp[2], kdp[3]};
        *(LAS u32x4*)(KD + ek * 144 + eseg * 32 + 16) = (u32x4){kdp[4], kdp[5], kdp[6], kdp[7]};
        __syncthreads();
        const int tt_ = wave >> 1;
        {
            bf16x8 bq[4];
#pragma unroll
            for (int ks = 0; ks < 4; ++ks) bq[ks] = *(const LAS bf16x8*)(QT + (16 * tt_ + l15) * 272 + ks * 64 + quad * 16);
#pragma unroll
            for (int u = 0; u < 2; ++u) { const int st = 2 * (wave & 1) + u;
                f32x4 a = (f32x4){0.f, 0.f, 0.f, 0.f};
                if (st <= tt_) {
#pragma unroll
                    for (int ks = 0; ks < 4; ++ks) { const bf16x8 ka = *(const LAS bf16x8*)(KT + (16 * st + l15) * 272 + ks * 64 + quad * 16); a = mfma16(ka, bq[ks], a); }
                }
                const int tq = 16 * tt_ + l15, sb = 16 * st + 4 * quad;
                const float a0 = (st <= tt_ && sb + 0 <= tq) ? a[0] : 0.f, a1 = (st <= tt_ && sb + 1 <= tq) ? a[1] : 0.f, a2 = (st <= tt_ && sb + 2 <= tq) ? a[2] : 0.f, a3 = (st <= tt_ && sb + 3 <= tq) ? a[3] : 0.f;
                u32x2 w; w.x = pk2(a0, a1); w.y = pk2(a2, a3);
                *(LAS u32x2*)(AT + tq * 144 + sb * 2) = w; }
        }
        __syncthreads();
        {
            bf16x8 bq[4], ba[2];
#pragma unroll
            for (int ks = 0; ks < 4; ++ks) bq[ks] = *(const LAS bf16x8*)(QG + (16 * tt_ + l15) * 272 + ks * 64 + quad * 16);
#pragma unroll
            for (int ks = 0; ks < 2; ++ks) ba[ks] = *(const LAS bf16x8*)(AT + (16 * tt_ + l15) * 144 + ks * 64 + quad * 16);
            u32x2 wv[2];
#pragma unroll
            for (int u = 0; u < 2; ++u) { const int vt = 2 * (wave & 1) + u;
                f32x4 a = (f32x4){0.f, 0.f, 0.f, 0.f};
#pragma unroll
                for (int ks = 0; ks < 4; ++ks) { const bf16x8 sa = *(const LAS bf16x8*)(ST + (16 * vt + l15) * 272 + ks * 64 + quad * 16); a = mfma16(sa, bq[ks], a); }
#pragma unroll
                for (int ks = 0; ks < 2; ++ks) { const bf16x8 va = *(const LAS bf16x8*)(VT + (16 * vt + l15) * 144 + ks * 64 + quad * 16); a = mfma16(va, ba[ks], a); }
                wv[u].x = pk2(a[0], a[1]); wv[u].y = pk2(a[2], a[3]); }
            *(u32x4*)(base + (size_t)(c * 64 + 16 * tt_ + l15) * IN_B + vcol + 16 * (2 * (wave & 1) + (quad & 1)) + 8 * (quad >> 1)) = swap16_pack(wv[0], wv[1]);
        }
        {
            bf16x8 ka[2];
#pragma unroll
            for (int ks = 0; ks < 2; ++ks) ka[ks] = *(const LAS bf16x8*)(KD + (16 * wave + l15) * 144 + ks * 64 + quad * 16);
            const f32x4 gl = *(const LAS f32x4*)(GL + (16 * wave + 4 * quad) * 4);
#pragma unroll
            for (int vt = 0; vt < 4; ++vt) { sacc[vt] = sacc[vt] * gl;
#pragma unroll
                for (int ks = 0; ks < 2; ++ks) { const bf16x8 vb = *(const LAS bf16x8*)(VT + (16 * vt + l15) * 144 + ks * 64 + quad * 16); sacc[vt] = mfma16(ka[ks], vb, sacc[vt]); } }
        }
        __syncthreads();
#pragma unroll
        for (int vt = 0; vt < 4; ++vt) { u32x2 w; w.x = pk2(sacc[vt][0], sacc[vt][1]); w.y = pk2(sacc[vt][2], sacc[vt][3]);
            *(LAS u32x2*)(ST + (16 * vt + l15) * 272 + (16 * wave + 4 * quad) * 2) = w; }
        if (c + 1 < 32) GLA_STORE();
    }
#undef GLA_LOAD
#undef GLA_STORE
}

DI void gate_A(bf16_t* cols, const float* lse, int ntok, int bid, int nb) {
    const int tid = launder_tid(), sub = tid & 127, h = sub >> 4, d8 = (sub & 15) * 8;
    constexpr int U = 4;
    for (int tok0 = bid * 4 + (tid >> 7); tok0 < ntok; tok0 += nb * 4 * U) {
        u32x4 o0[U], o1[U], o2[U], gt[U]; float l0[U], l1[U], l2[U];
#pragma unroll
        for (int u = 0; u < U; ++u) { const int tok = min(tok0 + u * nb * 4, ntok - 1); const bf16_t* rowp = cols + (size_t)tok * IN_A;
            l0[u] = lse[(size_t)tok * 24 + h]; l1[u] = lse[(size_t)tok * 24 + 8 + h]; l2[u] = lse[(size_t)tok * 24 + 16 + h];
            o0[u] = *(const u32x4*)(rowp + h * 128 + d8); o1[u] = *(const u32x4*)(rowp + 1024 + h * 128 + d8); o2[u] = *(const u32x4*)(rowp + 2048 + h * 128 + d8);
            gt[u] = *(const u32x4*)(rowp + 9728 + h * 128 + d8); }
#pragma unroll
        for (int u = 0; u < U; ++u) { const int tok = tok0 + u * nb * 4; if (tok >= ntok) continue;
            const float m = fmaxf(l0[u], fmaxf(l1[u], l2[u]));
            float w0 = __expf(l0[u] - m), w1 = __expf(l1[u] - m), w2 = __expf(l2[u] - m);
            const float inv = 1.f / (w0 + w1 + w2); w0 *= inv; w1 *= inv; w2 *= inv;
            u32x4 y;
#pragma unroll
            for (int e = 0; e < 4; ++e) {
                const float ylo = (w0 * bflo(o0[u][e]) + w1 * bflo(o1[u][e]) + w2 * bflo(o2[u][e])) * silu(bflo(gt[u][e]));
                const float yhi = (w0 * bfhi(o0[u][e]) + w1 * bfhi(o1[u][e]) + w2 * bfhi(o2[u][e])) * silu(bfhi(gt[u][e]));
                y[e] = pk2(ylo, yhi); }
            *(u32x4*)(cols + (size_t)tok * IN_A + 9728 + h * 128 + d8) = y; }
    }
}
DI void gate_B(bf16_t* cols, const float* ogain, int ntok, int bid, int nb) {
    const int tid = launder_tid(), sub = tid & 127, h = sub >> 4, d8 = (sub & 15) * 8;
    const GAS float* ogg = launder_g(ogain);
    const f32x4 g0 = *(const GAS f32x4*)(ogg + d8), g1 = *(const GAS f32x4*)(ogg + d8 + 4);
    constexpr int U = 4;
    for (int tok0 = bid * 4 + (tid >> 7); tok0 < ntok; tok0 += nb * 4 * U) {
        u32x4 ow[U], gt[U];
#pragma unroll
        for (int u = 0; u < U; ++u) { const bf16_t* rowp = cols + (size_t)(tok0 + u * nb * 4) * IN_B;
            ow[u] = *(const u32x4*)(rowp + 2048 + h * 128 + d8); gt[u] = *(const u32x4*)(rowp + 3584 + h * 128 + d8); }
#pragma unroll
        for (int u = 0; u < U; ++u) {
            float ov[8]; float ss = 0.f;
#pragma unroll
            for (int e = 0; e < 4; ++e) { ov[2 * e] = bflo(ow[u][e]); ov[2 * e + 1] = bfhi(ow[u][e]); }
#pragma unroll
            for (int e = 0; e < 8; ++e) ss += ov[e] * ov[e];
            ss += __shfl_xor(ss, 1); ss += __shfl_xor(ss, 2); ss += __shfl_xor(ss, 4); ss += __shfl_xor(ss, 8);
            const float rstd = rsqrtf(ss * (1.f / 128.f) + EPS);
            u32x4 y;
            y[0] = pk2(ov[0] * rstd * g0[0] * silu(bflo(gt[u][0])), ov[1] * rstd * g0[1] * silu(bfhi(gt[u][0])));
            y[1] = pk2(ov[2] * rstd * g0[2] * silu(bflo(gt[u][1])), ov[3] * rstd * g0[3] * silu(bfhi(gt[u][1])));
            y[2] = pk2(ov[4] * rstd * g1[0] * silu(bflo(gt[u][2])), ov[5] * rstd * g1[1] * silu(bfhi(gt[u][2])));
            y[3] = pk2(ov[6] * rstd * g1[2] * silu(bflo(gt[u][3])), ov[7] * rstd * g1[3] * silu(bfhi(gt[u][3])));
            *(u32x4*)(cols + (size_t)(tok0 + u * nb * 4) * IN_B + 3584 + h * 128 + d8) = y; }
    }
}

constexpr int NSTEPS = 26;
__device__ const unsigned char kSteps[NSTEPS][4] = {
    {0, 0, 0, 0}, {1, 0, 0, 0},
    {2, 0, 0, 0}, {3, 0, 0, 0}, {4, 0, 0, 0}, {5, 0, 0, 0}, {2, 0, 1, 0}, {3, 0, 1, 0}, {4, 0, 1, 1}, {5, 0, 1, 0},
    {2, 1, 0, 0}, {3, 1, 0, 0}, {4, 1, 0, 1}, {5, 1, 0, 0},
    {2, 2, 0, 0}, {3, 2, 0, 0}, {4, 2, 0, 0}, {5, 2, 0, 0}, {2, 2, 1, 0}, {3, 2, 1, 0}, {4, 2, 1, 1}, {5, 2, 1, 0},
    {2, 3, 0, 0}, {3, 3, 0, 0}, {4, 3, 0, 0}, {5, 3, 0, 0}};

__global__ void __launch_bounds__(NTHREADS, 2) fwd_megakernel(Params P) {
    extern __shared__ __attribute__((aligned(16))) unsigned char lds_raw[];
    LAS unsigned char* lds = (LAS unsigned char*)lds_raw;
    cg::grid_group grid = cg::this_grid();
    const int bid = blockIdx.x, nb = gridDim.x, tid = threadIdx.x;
    unsigned char* ws = P.ws;
    const float* x_in = P.in[0]; const float* mem = P.in[1]; const int* positions = (const int*)P.in[2];
    const float* norm_gain = P.in[3]; const float* w_in_a = P.in[4]; const float* q_gain_a = P.in[5]; const float* k_gain_a = P.in[6]; const float* w_out_a = P.in[7];
    const float* w_in_b = P.in[8]; const float* lb_logits = P.in[9]; const float* o_gain_b = P.in[10]; const float* w_out_b = P.in[11];
    const float* mem_norm_gain = P.in[12]; const float* w_mem_kv = P.in[13]; const float* mem_q_gain = P.in[14]; const float* mem_k_gain = P.in[15];
    bf16_t* WinT = (bf16_t*)(ws + WS_WIN); bf16_t* WoutT = (bf16_t*)(ws + WS_WOUT); bf16_t* XN = (bf16_t*)(ws + WS_XN); bf16_t* KVM = (bf16_t*)(ws + WS_KVM);
    bf16_t* MEMN = (bf16_t*)(ws + WS_MEMN); bf16_t* WkvT = (bf16_t*)(ws + WS_WKV); float* LSE = (float*)(ws + WS_LSE); float* LB = (float*)(ws + WS_LB); bf16_t* COLS = (bf16_t*)(ws + WS_COLS);
    float* ROT = (float*)(ws + WS_ROT);
    float* SSQ = (float*)(ws + WS_SSQ); bf16_t* WoutT2 = (bf16_t*)(ws + WS_WOUT2);
    float* out = P.out;
    volatile LAS unsigned* bst = (volatile LAS unsigned*)(lds + LDS_BYTES - 16);
    if (tid < 4) bst[tid] = 0u;
    __syncthreads();
    const XcdBarrier xbar = xcd_barrier_post((unsigned*)(ws + WS_BAR), bst);

    for (int step = 0; step < NSTEPS; ++step) {
        const int op = kSteps[step][0], l = kSteps[step][1], grp = kSteps[step][2];
        const int j = l >> 1; const bool isA = (l & 1) == 0;
        if (op == 0) {
            convert_wT(lds, w_in_a, norm_gain, WinT, DM, IN_A, bid, nb);
            convert_wT(lds, w_out_a, nullptr, WoutT, MIXW, DM, bid, nb);
            prep_rows(x_in, XN, SSQ, T_TOK, bid, nb);
            for (int q = 0; q < 4; ++q) convert_wT(lds, w_mem_kv + (size_t)q * DM * 1024, mem_norm_gain + q * DM, WkvT + (size_t)q * 1024 * DM, DM, 1024, bid, nb);
            norm_rows(mem, MEMN, 4096, bid, nb);
            {
                for (int e = bid * NTHREADS + launder_tid(); e < T_TOK * 16; e += nb * NTHREADS) {
                    const int tok = e >> 4, i = e & 15; float cs, sn; rot_cs(positions[tok], kRotF[i], cs, sn);
                    ROT[(size_t)tok * 32 + i] = cs; ROT[(size_t)tok * 32 + 16 + i] = sn; }
                for (int c = bid * NTHREADS + launder_tid(); c < 1024; c += nb * NTHREADS) {
                    const float a0 = lb_logits[c], a1 = lb_logits[1024 + c], a2 = lb_logits[2048 + c], a3 = lb_logits[3072 + c];
                    const float m = fmaxf(fmaxf(a0, a1), fmaxf(a2, a3));
                    const float e0 = __expf(a0 - m), e1 = __expf(a1 - m), e2 = __expf(a2 - m), e3 = __expf(a3 - m), inv = 1.f / (e0 + e1 + e2 + e3);
                    LB[c] = e1 * inv; LB[1024 + c] = (e1 + e2 + e3) * inv;
                }
            }
        } else if (op == 1 || op == 2 || op == 5) {
            pg8::Gemm g; pg8::Epi E; E.O = nullptr; E.ldc = 0; E.ssq_in = nullptr; E.X = nullptr; E.C = nullptr; E.ssq_out = nullptr;
            if (op == 1)      { g.A = MEMN; g.Bt = WkvT; g.M = 4096; g.N = 4096; g.K = DM; g.lda = DM; E.mode = 0; E.O = KVM; E.ldc = 4096; }
            else if (op == 2) { const int ldc = isA ? IN_A : IN_B; g.A = XN + (size_t)grp * 16384 * DM; g.Bt = WinT; g.M = isA ? 16384 : T_TOK; g.N = ldc; g.K = DM; g.lda = DM; E.mode = 0; E.O = COLS; E.ldc = ldc;
                                E.ssq_in = SSQ + (size_t)grp * 16384 * 16; }
            else              { const int ldc = isA ? IN_A : IN_B; g.A = COLS + (isA ? 9728 : 3584); g.Bt = (l & 1) ? WoutT2 : WoutT; g.M = isA ? 16384 : T_TOK; g.N = DM; g.K = MIXW; g.lda = ldc; E.mode = 1;
                                E.X = XN + (size_t)grp * 16384 * DM;
                                if (l == 3) E.C = out + (size_t)grp * 16384 * DM; else E.ssq_out = SSQ + (size_t)grp * 16384 * 16; }
            pg8::StaticOrder S; S.init(g.M, g.N, nb, bid);
            pg8::gemm_phase(lds, g, S, E);
        } else if (op == 3) {
            if (isA) { for (int it = bid; it < 1536; it += nb) dil_chain(lds, COLS, LSE, ROT, q_gain_a + j * 384, k_gain_a + j * 384, it, grp); }
            else     { for (int it = bid; it < 256; it += nb) gla_item(lds, COLS, LB + j * 1024, it); }
            const int ldc = isA ? IN_A : IN_B, qmoff = isA ? 9216 : 3072, gmoff = isA ? (9728 + 1024) : (3584 + 1024), nq = isA ? 2 : 4;
            for (int it = bid; it < 256; it += nb) mem_attn_unit(lds, COLS, ldc, qmoff, gmoff, KVM, l, mem_q_gain + l * 128, mem_k_gain + l * 128, it, grp * 8, nq);
        } else {
            if (isA) gate_A(COLS, LSE, 16384, bid, nb); else gate_B(COLS, o_gain_b + j * 128, T_TOK, bid, nb);
            if (kSteps[step][3]) {
                const int l1 = l + 1, j1 = l1 >> 1; const bool a1 = (l1 & 1) == 0;
                const float* win = a1 ? w_in_a + (size_t)j1 * DM * IN_A : w_in_b + (size_t)j1 * DM * IN_B;
                const float* wout = a1 ? w_out_a + (size_t)j1 * MIXW * DM : w_out_b + (size_t)j1 * MIXW * DM;
                convert_wT(lds, win, norm_gain + l1 * DM, WinT, DM, a1 ? IN_A : IN_B, bid, nb);
                convert_wT(lds, wout, nullptr, (l1 & 1) ? WoutT2 : WoutT, MIXW, DM, bid, nb);
            }
        }
        if (op == 1) continue;
        if (nb > (1 << 20)) grid.sync();
        xcd_barrier(xbar);
    }
}

extern "C" void kernel_launch(void* const* d_in, const int* in_sizes, int n_in, void* d_out, int out_size, void* d_ws, size_t ws_size, hipStream_t stream) {
    static int grid_blocks = 0;
    if (grid_blocks == 0) {
        if (n_in != 16 || out_size != T_TOK * DM || ws_size < WS_END) { fprintf(stderr, "kernel_launch: unexpected shapes (n_in %d out %d ws %zu need %zu)\n", n_in, out_size, ws_size, (size_t)WS_END); grid_blocks = -1; return; }
        int dev = 0, cus = 0, per_cu = 0;
        (void)hipGetDevice(&dev);
        (void)hipDeviceGetAttribute(&cus, hipDeviceAttributeMultiprocessorCount, dev);
        if (hipFuncSetAttribute((const void*)fwd_megakernel, hipFuncAttributeMaxDynamicSharedMemorySize, LDS_BYTES) != hipSuccess) { fprintf(stderr, "kernel_launch: hipFuncSetAttribute failed\n"); grid_blocks = -1; return; }
        (void)hipOccupancyMaxActiveBlocksPerMultiprocessor(&per_cu, (const void*)fwd_megakernel, NTHREADS, LDS_BYTES);
        if (per_cu < 1) per_cu = 1;
        grid_blocks = cus * per_cu;
        (void)hipGetLastError();
    }
    if (grid_blocks < 0) return;
    if (hipMemsetAsync((char*)d_ws + WS_BAR, 0, XCD_BAR_WORDS * 4, stream) != hipSuccess) { fprintf(stderr, "kernel_launch: memset of barrier words failed\n"); return; }
    Params p{};
    for (int i = 0; i < 16; ++i) p.in[i] = (const float*)d_in[i];
    p.out = (float*)d_out; p.ws = (unsigned char*)d_ws;
    void* args[] = {&p};
    hipError_t e = hipLaunchCooperativeKernel((const void*)fwd_megakernel, dim3(grid_blocks), dim3(NTHREADS), args, LDS_BYTES, stream);
    if (e != hipSuccess) fprintf(stderr, "cooperative launch failed: %s (grid %d)\n", hipGetErrorString(e), grid_blocks);
}
```

```cpp
#include <hip/hip_runtime.h>
#include <hip/hip_cooperative_groups.h>
#include <cstdio>
namespace cg = cooperative_groups;

#define DI __device__ __forceinline__
#define LAS __attribute__((address_space(3)))
typedef unsigned short bf16_t;
typedef short bf16x8 __attribute__((ext_vector_type(8)));
typedef short s16x4 __attribute__((ext_vector_type(4)));
typedef float f32x4 __attribute__((ext_vector_type(4)));
typedef unsigned u32x4 __attribute__((ext_vector_type(4)));
typedef unsigned u32x2 __attribute__((ext_vector_type(2)));

constexpr int T_TOK = 32768, DM = 1024, SEQ = 2048;
constexpr int IN_A = 11264, IN_B = 5120, MIXW = 1536;
constexpr int NTHREADS = 512;
constexpr int LDS_BYTES = 149504;
constexpr int SSQ_LDS_OFF = 131072;
constexpr float EPS = 1e-6f;
constexpr float QSCALE = 0.12751743082459868f;
constexpr float LN2 = 0.6931471805599453f;

constexpr size_t WS_WIN  = 0;
constexpr size_t WS_WOUT = WS_WIN + (size_t)IN_A * DM * 2;
constexpr size_t WS_XN   = WS_WOUT + (size_t)DM * MIXW * 2;
constexpr size_t WS_KVM  = WS_XN + (size_t)T_TOK * DM * 2;
constexpr size_t WS_MEMN = WS_KVM + (size_t)4096 * 4096 * 2;
constexpr size_t WS_WKV  = WS_MEMN + (size_t)4096 * 1024 * 2;
constexpr size_t WS_LSE  = WS_WKV + (size_t)4096 * 1024 * 2;
constexpr size_t WS_LB   = WS_LSE + (size_t)16384 * 24 * 4;
constexpr size_t WS_COLS = WS_LB + 8192;
constexpr size_t WS_BAR  = WS_COLS + (size_t)16384 * IN_A * 2;
constexpr size_t WS_ROT  = WS_BAR + 16384;
constexpr size_t WS_SSQ  = WS_ROT + (size_t)T_TOK * 32 * 4;
constexpr size_t WS_WOUT2 = WS_SSQ + (size_t)T_TOK * 16 * 4;
constexpr size_t WS_END  = WS_WOUT2 + (size_t)DM * MIXW * 2;

struct Params { const float* in[16]; float* out; unsigned char* ws; };

#define GAS __attribute__((address_space(1)))
template <class T> DI const GAS T* launder_g(const T* p) { asm volatile("" : "+s"(p)); return (const GAS T*)p; }
DI int launder_tid() { int t = threadIdx.x; asm volatile("" : "+v"(t)); return t; }
DI float bf2f(unsigned short h) { return __uint_as_float(((unsigned)h) << 16); }
DI float bflo(unsigned u) { return __uint_as_float(u << 16); }
DI float bfhi(unsigned u) { return __uint_as_float(u & 0xffff0000u); }
typedef __bf16 bf16x2_t __attribute__((ext_vector_type(2)));
typedef float f32x2_t __attribute__((ext_vector_type(2)));
DI unsigned pk2(float lo, float hi) { const f32x2_t v = {lo, hi}; const bf16x2_t b = __builtin_convertvector(v, bf16x2_t); return __builtin_bit_cast(unsigned, b); }
DI unsigned short f2bf(float x) { return (unsigned short)(pk2(x, x) & 0xffffu); }
DI u32x4 swap16_pack(u32x2 a, u32x2 b) {
    const u32x2 X = __builtin_amdgcn_permlane16_swap(a.x, b.x, false, false);
    const u32x2 Y = __builtin_amdgcn_permlane16_swap(a.y, b.y, false, false);
    return (u32x4){X.x, Y.x, X.y, Y.y};
}
DI float silu(float g) { return g / (1.f + __expf(-g)); }
DI f32x4 mfma16(bf16x8 a, bf16x8 b, f32x4 c) { return __builtin_amdgcn_mfma_f32_16x16x32_bf16(a, b, c, 0, 0, 0); }


#define XB_TMO      128
#define XB_XCNT(j)  (256  + 64 * (j))
#define XB_XSUB(j)  (1280 + 64 * (j))
#define XB_XGEN(j)  (2304 + 64 * (j))
#define XB_TOP      3328
#define XB_TOPGEN   3392
#define XCD_BAR_WORDS 3456
#define XB_SPIN_CAP (1u << 18)
DI unsigned xb_ld(unsigned* p)              { return __hip_atomic_load(p, __ATOMIC_RELAXED, __HIP_MEMORY_SCOPE_AGENT); }
DI unsigned xb_add(unsigned* p, unsigned v) { return __hip_atomic_fetch_add(p, v, __ATOMIC_RELAXED, __HIP_MEMORY_SCOPE_AGENT); }
DI unsigned xb_xcc_id() { return (unsigned)__builtin_amdgcn_s_getreg((3 << 11) | 20) & 0xFu; }
#define XB_SPIN(cond, bar) do { unsigned _sp = 0; while (cond) { __builtin_amdgcn_s_sleep(1); \
    if ((++_sp & 255u) == 0u) { if (xb_ld(&(bar)[XB_TMO])) break; if (_sp > XB_SPIN_CAP) { atomicAdd(&(bar)[XB_TMO], 1u); break; } } } } while (0)
struct XcdBarrier { unsigned* bar; unsigned x; volatile LAS unsigned* st; };
DI XcdBarrier xcd_barrier_post(unsigned* bar, volatile LAS unsigned* st) {
    XcdBarrier b; b.bar = bar; b.x = xb_xcc_id(); b.st = st;
    if (threadIdx.x == 0) (void)xb_add(&bar[XB_XCNT(b.x)], 1u);
    return b;
}
DI void xcd_barrier_complete(unsigned* bar, unsigned x, unsigned& nloc, unsigned& nx) {
    const unsigned G = gridDim.x * gridDim.y * gridDim.z;
    unsigned sum, cnt, mine, sp = 0u;
    for (;;) {
        sum = 0u; cnt = 0u; mine = 0u;
#pragma unroll
        for (unsigned j = 0; j < 16; ++j) { const unsigned c = xb_ld(&bar[XB_XCNT(j)]); sum += c; cnt += (c > 0u) ? 1u : 0u; mine = (j == x) ? c : mine; }
        if (sum == G) break;
        __builtin_amdgcn_s_sleep(1);
        if ((++sp & 255u) == 0u) { if (xb_ld(&bar[XB_TMO])) break; if (sp > XB_SPIN_CAP) { atomicAdd(&bar[XB_TMO], 1u); break; } }
    }
    nloc = mine > 0u ? mine : 1u; nx = cnt > 0u ? cnt : 1u;
}
DI void xcd_barrier(const XcdBarrier& b) {
    asm volatile("s_waitcnt vmcnt(0)" ::: "memory");
    __syncthreads();
    if (threadIdx.x == 0) {
        unsigned* bar = b.bar;
        __builtin_amdgcn_s_waitcnt(0);
        unsigned nloc = b.st[0], nx = b.st[1];
        if (nloc == 0u) { xcd_barrier_complete(bar, b.x, nloc, nx); b.st[0] = nloc; b.st[1] = nx; }
        const unsigned old = xb_add(&bar[XB_XSUB(b.x)], 1u);
        const unsigned gen = old / nloc;
        if (old + 1u == (gen + 1u) * nloc) {
            __builtin_amdgcn_fence(__ATOMIC_RELEASE, "agent");
            asm volatile("s_waitcnt vmcnt(0)" ::: "memory");
            const unsigned og = xb_add(&bar[XB_TOP], 1u);
            const unsigned tg = og / nx;
            if (og + 1u == (tg + 1u) * nx) xb_add(&bar[XB_TOPGEN], 1u);
            else XB_SPIN(xb_ld(&bar[XB_TOPGEN]) == tg, bar);
            __builtin_amdgcn_fence(__ATOMIC_ACQUIRE, "agent");
            xb_add(&bar[XB_XGEN(b.x)], 1u);
            asm volatile("s_waitcnt vmcnt(0)" ::: "memory");
        } else {
            XB_SPIN(xb_ld(&bar[XB_XGEN(b.x)]) == gen, bar);
            __builtin_amdgcn_fence(__ATOMIC_ACQUIRE, "agent");
            asm volatile("s_waitcnt vmcnt(0)" ::: "memory");
        }
    }
    __syncthreads();
}

namespace pg8 {
constexpr int BM = 256, BK = 64, HALF = 128, HTB = HALF * BK * 2, STAGE_BYTES = 8 * HTB, NXCD = 8, WGM = 8;
DI int lds_byte(int r, int c) { const int st = (r >> 4) * 2 + (c >> 5), rr = r & 15, cc = c & 31, ob = rr * 64 + cc * 2; return st * 1024 + (ob ^ (((ob >> 9) & 1) << 5)); }
DI void stage_rc(int b, int& R, int& C) { const int st = b / 1024, sb = b % 1024, swz = sb ^ (((sb >> 9) & 1) << 5); R = (st >> 1) * 16 + swz / 64; C = (st & 1) * 32 + (swz % 64) / 2; }
DI int perm32(int rho) { const int n = rho >> 4, i = rho & 15; return 8 * (i >> 2) + 4 * n + (i & 3); }
struct Unit { int pm, pn; };
struct Gemm { const bf16_t* A; const bf16_t* Bt; int M, N, K, lda; };
struct StaticOrder {
    int nM, nN, nwg, G, c;
    DI void init(int M, int N, int G_, int c_) { nM = M / BM; nN = N / BM; nwg = nM * nN; G = G_; c = c_; }
    DI bool next(int i, Unit& u) const {
        const long L = (long)i * G + c; if (L >= nwg) return false;
        int wgid = (int)L; { const int q = nwg / NXCD, r = nwg % NXCD, xcd = wgid % NXCD, off = wgid / NXCD; wgid = (xcd < r ? xcd * (q + 1) : r * (q + 1) + (xcd - r) * q) + off; }
        const int nig = WGM * nN, gid = wgid / nig, fm = gid * WGM, gsz = (nM - fm) < WGM ? (nM - fm) : WGM;
        u.pm = fm + ((wgid % nig) % gsz); u.pn = (wgid % nig) / gsz; return true;
    }
};
struct Epi {
    int mode; bf16_t* O; int ldc;
    const float* ssq_in;
    bf16_t* X;
    float* C;
    float* ssq_out;
    DI void operator()(const f32x4 (&acc)[2][2][4][2], const Unit& u, int wr, int wc, int fr, int fq, LAS unsigned char* lds) const {
        if (mode == 0) {
            const int row0 = u.pm * BM + wr * 64 + fr, col0 = u.pn * BM + wc * 32 + 8 * fq;
            float rs[2][4];
#pragma unroll
            for (int ai = 0; ai < 2; ++ai)
#pragma unroll
                for (int m = 0; m < 4; ++m) rs[ai][m] = 1.f;
            if (ssq_in) {
                f32x4 pp[2][4];
#pragma unroll
                for (int ai = 0; ai < 2; ++ai)
#pragma unroll
                    for (int m = 0; m < 4; ++m) pp[ai][m] = *(const LAS f32x4*)(lds + SSQ_LDS_OFF + (wr * 64 + fr + ai * HALF + m * 16) * 64 + fq * 16);
#pragma unroll
                for (int ai = 0; ai < 2; ++ai)
#pragma unroll
                    for (int m = 0; m < 4; ++m) { float s = (pp[ai][m][0] + pp[ai][m][1]) + (pp[ai][m][2] + pp[ai][m][3]); s += __shfl_xor(s, 16); s += __shfl_xor(s, 32); rs[ai][m] = rsqrtf(s * (1.f / DM) + EPS); }
            }
            const __amdgpu_buffer_rsrc_t orsrc = __builtin_amdgcn_make_buffer_rsrc((void*)O, (short)0, 0x7fffffff, 0x00020000);
#pragma unroll
            for (int ai = 0; ai < 2; ++ai)
#pragma unroll
                for (int m = 0; m < 4; ++m) { const unsigned ro = (unsigned)(((size_t)(row0 + ai * HALF + m * 16) * ldc + col0) * 2);
#pragma unroll
                    for (int bj = 0; bj < 2; ++bj) { const f32x4 v0 = acc[ai][bj][m][0] * rs[ai][m], v1 = acc[ai][bj][m][1] * rs[ai][m];
                        u32x4 w; w.x = pk2(v0[0], v0[1]); w.y = pk2(v0[2], v0[3]); w.z = pk2(v1[0], v1[1]); w.w = pk2(v1[2], v1[3]);
                        __builtin_amdgcn_raw_buffer_store_b128(w, orsrc, ro + bj * HALF * 2, 0, 16); } }
        } else {
            const int row0 = u.pm * BM + wr * 64 + fr, col0 = u.pn * BM + wc * 32 + 8 * fq;
#pragma unroll
            for (int ai = 0; ai < 2; ++ai) {
                u32x4 rb[4][2];
#pragma unroll
                for (int m = 0; m < 4; ++m)
#pragma unroll
                    for (int bj = 0; bj < 2; ++bj) rb[m][bj] = *(const u32x4*)(X + (size_t)(row0 + ai * HALF + m * 16) * DM + col0 + bj * HALF);
#pragma unroll
                for (int m = 0; m < 4; ++m) {
                    const size_t ro = (size_t)(row0 + ai * HALF + m * 16) * DM + col0;
                    float ssp = 0.f;
#pragma unroll
                    for (int bj = 0; bj < 2; ++bj) { const u32x4 r = rb[m][bj];
                        f32x4 v0 = acc[ai][bj][m][0], v1 = acc[ai][bj][m][1];
                        v0[0] += bflo(r.x); v0[1] += bfhi(r.x); v0[2] += bflo(r.y); v0[3] += bfhi(r.y); v1[0] += bflo(r.z); v1[1] += bfhi(r.z); v1[2] += bflo(r.w); v1[3] += bfhi(r.w);
                        if (C) { *(f32x4*)(C + ro + bj * HALF) = v0; *(f32x4*)(C + ro + bj * HALF + 4) = v1; }
                        else { u32x4 w; w.x = pk2(v0[0], v0[1]); w.y = pk2(v0[2], v0[3]); w.z = pk2(v1[0], v1[1]); w.w = pk2(v1[2], v1[3]); *(u32x4*)(X + ro + bj * HALF) = w;
                            const float b0 = bflo(w.x), b1 = bfhi(w.x), b2 = bflo(w.y), b3 = bfhi(w.y), b4 = bflo(w.z), b5 = bfhi(w.z), b6 = bflo(w.w), b7 = bfhi(w.w);
                            ssp += ((b0 * b0 + b1 * b1) + (b2 * b2 + b3 * b3)) + ((b4 * b4 + b5 * b5) + (b6 * b6 + b7 * b7)); } }
                    if (!C) { ssp += __shfl_xor(ssp, 16); ssp += __shfl_xor(ssp, 32);
                        if (fq == 0) ssq_out[(size_t)(row0 + ai * HALF + m * 16) * 16 + u.pn * 4 + wc] = ssp; }
                }
            }
        }
    }
};

DI void gemm_phase(LAS unsigned char* lds, const Gemm g, const StaticOrder& S, const Epi& E) {
    const int tid = launder_tid(), wid = __builtin_amdgcn_readfirstlane(tid >> 6), lane = tid & 63, wr = wid >> 2, wc = wid & 3, fr = lane & 15, fq = lane >> 4;
    const int K = g.K, nt = K / BK, lda = g.lda;
    unsigned voffA[2], voffB[2];
#pragma unroll
    for (int i = 0; i < 2; ++i) { int R, C; stage_rc(tid * 16 + i * 8192, R, C); const int Rb = (R & ~31) + perm32(R & 31);
        voffA[i] = (unsigned)(R * lda + C) * 2u; voffB[i] = (unsigned)(Rb * K + C) * 2u; }
    const size_t kstep = (size_t)(BK * 2);
    const size_t hstepA = (size_t)HALF * lda * 2, hstepB = (size_t)HALF * K * 2;
    const size_t tstepA = 2 * hstepA, tstepB = 2 * hstepB;
    const unsigned ldsw = (unsigned)wid * 1024u;
    const int aoff = lds_byte(wr * 64 + fr, fq * 8), boff = lds_byte(wc * 32 + fr, fq * 8);
#define PG8_SA(b, h) (((b) * 2 + (h)) * HTB)
#define PG8_SB(b, h) ((4 + (b) * 2 + (h)) * HTB)
#define PG8_STAGE(bufoff, gbase, voff) do { _Pragma("unroll") for (int _i = 0; _i < 2; ++_i) \
        __builtin_amdgcn_global_load_lds((const unsigned*)((const char*)(gbase) + (voff)[_i]), (LAS unsigned*)(lds + (bufoff) + ldsw + _i * 8192), 16, 0, 0); } while (0)
#define PG8_LDA(dst, b, h) do { _Pragma("unroll") for (int m = 0; m < 4; ++m) _Pragma("unroll") for (int k = 0; k < 2; ++k) dst[m][k] = *(const LAS bf16x8*)(lds + PG8_SA(b, h) + aoff + m * 2048 + k * 1024); } while (0)
#define PG8_LDB(dst, b, h) do { _Pragma("unroll") for (int n = 0; n < 2; ++n) _Pragma("unroll") for (int k = 0; k < 2; ++k) dst[n][k] = *(const LAS bf16x8*)(lds + PG8_SB(b, h) + boff + n * 2048 + k * 1024); } while (0)
#define PG8_MMA(ai, bj, At, Bt) do { __builtin_amdgcn_s_setprio(1); _Pragma("unroll") for (int m = 0; m < 4; ++m) _Pragma("unroll") for (int n = 0; n < 2; ++n) _Pragma("unroll") for (int k = 0; k < 2; ++k) \
        acc[ai][bj][m][n] = __builtin_amdgcn_mfma_f32_16x16x32_bf16(Bt[n][k], At[m][k], acc[ai][bj][m][n], 0, 0, 0); __builtin_amdgcn_s_setprio(0); } while (0)
#define PG8_WAIT_V(n) asm volatile("s_waitcnt vmcnt(" #n ")" ::: "memory")
#define PG8_WAIT_L(n) asm volatile("s_waitcnt lgkmcnt(" #n ")" ::: "memory")
#define PG8_BAR __builtin_amdgcn_s_barrier()
#define PG8_SCHED __builtin_amdgcn_sched_barrier(0)
    Unit cur, nxt; int ui = 0;
    if (!S.next(0, cur)) return;
    f32x4 acc[2][2][4][2];
#pragma unroll
    for (int a = 0; a < 2; ++a)
#pragma unroll
        for (int b = 0; b < 2; ++b)
#pragma unroll
            for (int m = 0; m < 4; ++m)
#pragma unroll
                for (int n = 0; n < 2; ++n) acc[a][b][m][n] = (f32x4){0.f, 0.f, 0.f, 0.f};
    bf16x8 At[4][2], B0[2][2], B1[2][2];
    const char* cA = (const char*)g.A + (size_t)cur.pm * tstepA; const char* cB = (const char*)g.Bt + (size_t)cur.pn * tstepB;
    PG8_STAGE(PG8_SB(0, 0), cB, voffB); PG8_STAGE(PG8_SB(0, 1), cB + hstepB, voffB); PG8_STAGE(PG8_SA(0, 0), cA, voffA); PG8_STAGE(PG8_SA(0, 1), cA + hstepA, voffA);
    if (wr == 1) PG8_BAR;
    PG8_WAIT_V(2); PG8_BAR;
    PG8_STAGE(PG8_SB(1, 0), cB + kstep, voffB); PG8_STAGE(PG8_SA(1, 0), cA + kstep, voffA); PG8_STAGE(PG8_SB(1, 1), cB + hstepB + kstep, voffB);
    PG8_WAIT_V(6); PG8_BAR;
    for (;;) {
        const bool has_next = S.next(ui + 1, nxt);
        const char* nA = has_next ? (const char*)g.A + (size_t)nxt.pm * tstepA : cA; const char* nB = has_next ? (const char*)g.Bt + (size_t)nxt.pn * tstepB : cB;
        for (int t = 0; t < nt; t += 2) {
            const bool last = (t == nt - 2);
            const char* a1 = cA + (size_t)(t + 1) * kstep;
            const char* a2 = last ? nA : cA + (size_t)(t + 2) * kstep; const char* b2 = last ? nB : cB + (size_t)(t + 2) * kstep;
            const char* a3 = a2 + kstep; const char* b3 = b2 + kstep;
            if (last && E.ssq_in) {
                const char* sp = (const char*)(E.ssq_in + (size_t)cur.pm * BM * 16) + (size_t)wid * 2048 + (size_t)lane * 16;
                __builtin_amdgcn_global_load_lds((const unsigned*)sp, (LAS unsigned*)(lds + SSQ_LDS_OFF + wid * 2048), 16, 0, 0);
                __builtin_amdgcn_global_load_lds((const unsigned*)(sp + 1024), (LAS unsigned*)(lds + SSQ_LDS_OFF + wid * 2048 + 1024), 16, 0, 0);
                __builtin_amdgcn_sched_barrier(0);
            }
            PG8_LDB(B0, 0, 0); PG8_LDB(B1, 0, 1); PG8_SCHED; PG8_LDA(At, 0, 0); PG8_STAGE(PG8_SA(1, 1), a1 + hstepA, voffA);
            PG8_WAIT_V(8); PG8_WAIT_L(0); PG8_BAR; PG8_MMA(0, 0, At, B0); PG8_MMA(0, 1, At, B1); PG8_BAR; PG8_SCHED;
            PG8_LDA(At, 0, 1); PG8_STAGE(PG8_SB(0, 0), b2, voffB); PG8_STAGE(PG8_SB(0, 1), b2 + hstepB, voffB); PG8_STAGE(PG8_SA(0, 0), a2, voffA);
            PG8_WAIT_V(8); PG8_WAIT_L(0); PG8_BAR; PG8_MMA(1, 0, At, B0); PG8_MMA(1, 1, At, B1); PG8_BAR; PG8_SCHED;
            PG8_LDB(B0, 1, 0); PG8_LDB(B1, 1, 1); PG8_SCHED; PG8_LDA(At, 1, 0); PG8_STAGE(PG8_SA(0, 1), a2 + hstepA, voffA);
            PG8_WAIT_V(8); PG8_WAIT_L(0); PG8_BAR; PG8_MMA(0, 0, At, B0); PG8_MMA(0, 1, At, B1); PG8_BAR; PG8_SCHED;
            PG8_LDA(At, 1, 1); PG8_STAGE(PG8_SB(1, 0), b3, voffB); PG8_STAGE(PG8_SB(1, 1), b3 + hstepB, voffB); PG8_STAGE(PG8_SA(1, 0), a3, voffA);
            PG8_WAIT_V(8); PG8_WAIT_L(0); PG8_BAR; PG8_MMA(1, 0, At, B0); PG8_MMA(1, 1, At, B1); PG8_BAR; PG8_SCHED;
        }
        if (wr == 0) PG8_BAR;
        E(acc, cur, wr, wc, fr, fq, lds);
        if (!has_next) break;
#pragma unroll
        for (int a = 0; a < 2; ++a)
#pragma unroll
            for (int b = 0; b < 2; ++b)
#pragma unroll
                for (int m = 0; m < 4; ++m)
#pragma unroll
                    for (int n = 0; n < 2; ++n) acc[a][b][m][n] = (f32x4){0.f, 0.f, 0.f, 0.f};
        cur = nxt; cA = nA; cB = nB; ++ui;
        if (wr == 1) PG8_BAR;
    }
    PG8_WAIT_V(0);
    PG8_BAR;
#undef PG8_SA
#undef PG8_SB
#undef PG8_STAGE
#undef PG8_LDA
#undef PG8_LDB
#undef PG8_MMA
#undef PG8_WAIT_V
#undef PG8_WAIT_L
#undef PG8_BAR
#undef PG8_SCHED
}
}

DI void convert_wT(LAS unsigned char* lds, const float* W, const float* gain, bf16_t* Wt, int K, int N, int bid, int nb) {
    LAS bf16_t* tile = (LAS bf16_t*)lds;
    const int tid = launder_tid();
    const int ntn = N / 64, ntiles = (K / 64) * ntn;
    const int kk = tid >> 3, c8 = (tid & 7) * 8;
    f32x4 a, b; float g = 1.f;
    if (bid < ntiles) { const int k0 = (bid / ntn) * 64, n0 = (bid % ntn) * 64; const float* src = W + (size_t)(k0 + kk) * N + n0 + c8; a = *(const f32x4*)src; b = *(const f32x4*)(src + 4); g = gain ? gain[k0 + kk] : 1.f; }
    for (int t = bid; t < ntiles; t += nb) {
        const int k0 = (t / ntn) * 64, n0 = (t % ntn) * 64;
        const f32x4 ca = a, cb = b; const float cg = g;
        if (t + nb < ntiles) { const int k1 = ((t + nb) / ntn) * 64, n1 = ((t + nb) % ntn) * 64; const float* src = W + (size_t)(k1 + kk) * N + n1 + c8; a = *(const f32x4*)src; b = *(const f32x4*)(src + 4); g = gain ? gain[k1 + kk] : 1.f; }
        __syncthreads();
        tile[(c8 + 0) * 72 + kk] = f2bf(ca[0] * cg); tile[(c8 + 1) * 72 + kk] = f2bf(ca[1] * cg);
        tile[(c8 + 2) * 72 + kk] = f2bf(ca[2] * cg); tile[(c8 + 3) * 72 + kk] = f2bf(ca[3] * cg);
        tile[(c8 + 4) * 72 + kk] = f2bf(cb[0] * cg); tile[(c8 + 5) * 72 + kk] = f2bf(cb[1] * cg);
        tile[(c8 + 6) * 72 + kk] = f2bf(cb[2] * cg); tile[(c8 + 7) * 72 + kk] = f2bf(cb[3] * cg);
        __syncthreads();
        const int n = tid >> 3, k8 = (tid & 7) * 8;
        const u32x4 v = *(LAS u32x4*)(tile + n * 72 + k8);
        *(u32x4*)(Wt + (size_t)(n0 + n) * K + k0 + k8) = v;
    }
    __syncthreads();
}

DI void norm_rows(const float* x, bf16_t* xn, int nrows, int bid, int nb) {
    const int tid_ = launder_tid(); const int wave = tid_ >> 6, lane = tid_ & 63;
    for (int row0 = (bid * 8 + wave) * 4; row0 < nrows; row0 += nb * 32) {
        f32x4 v[4][4];
#pragma unroll
        for (int r = 0; r < 4; ++r) { const f32x4* src = (const f32x4*)(x + (size_t)(row0 + r) * DM);
#pragma unroll
            for (int i = 0; i < 4; ++i) v[r][i] = src[lane + 64 * i]; }
#pragma unroll
        for (int r = 0; r < 4; ++r) {
            float ss = 0.f;
#pragma unroll
            for (int i = 0; i < 4; ++i) ss += v[r][i][0] * v[r][i][0] + v[r][i][1] * v[r][i][1] + v[r][i][2] * v[r][i][2] + v[r][i][3] * v[r][i][3];
#pragma unroll
            for (int o = 32; o >= 1; o >>= 1) ss += __shfl_xor(ss, o);
            const float rstd = rsqrtf(ss * (1.f / DM) + EPS);
#pragma unroll
            for (int i = 0; i < 4; ++i) { u32x2 w; w.x = pk2(v[r][i][0] * rstd, v[r][i][1] * rstd); w.y = pk2(v[r][i][2] * rstd, v[r][i][3] * rstd);
                *(u32x2*)(xn + (size_t)(row0 + r) * DM + (lane + 64 * i) * 4) = w; }
        }
    }
}

DI void prep_rows(const float* x, bf16_t* xn, float* ssq, int nrows, int bid, int nb) {
    const int tid_ = launder_tid(); const int wave = tid_ >> 6, lane = tid_ & 63;
    for (int row0 = (bid * 8 + wave) * 4; row0 < nrows; row0 += nb * 32) {
        f32x4 v[4][4];
#pragma unroll
        for (int r = 0; r < 4; ++r) { const f32x4* src = (const f32x4*)(x + (size_t)(row0 + r) * DM);
#pragma unroll
            for (int i = 0; i < 4; ++i) v[r][i] = src[lane + 64 * i]; }
#pragma unroll
        for (int r = 0; r < 4; ++r) {
            float ss = 0.f;
#pragma unroll
            for (int i = 0; i < 4; ++i) { u32x2 w; w.x = pk2(v[r][i][0], v[r][i][1]); w.y = pk2(v[r][i][2], v[r][i][3]);
                *(u32x2*)(xn + (size_t)(row0 + r) * DM + (lane + 64 * i) * 4) = w;
                const float b0 = bflo(w.x), b1 = bfhi(w.x), b2 = bflo(w.y), b3 = bfhi(w.y); ss += (b0 * b0 + b1 * b1) + (b2 * b2 + b3 * b3); }
#pragma unroll
            for (int o = 32; o >= 1; o >>= 1) ss += __shfl_xor(ss, o);
            if (lane < 16) ssq[(size_t)(row0 + r) * 16 + lane] = (lane == 0) ? ss : 0.f;
        }
    }
}

constexpr int KVS = 272;
template <int NT, bool DIL>
DI void attn_core(LAS unsigned char* Kl, LAS unsigned char* Vl, const bf16x8 (&qf)[4], int k0, int qi, bool noprev, int flip, f32x4 (&o)[8], float& m_out, float& l_out) {
    const int lane = launder_tid() & 63, l15 = lane & 15, quad = lane >> 4;
    f32x4 s[NT];
#pragma unroll
    for (int kt = 0; kt < NT; ++kt) {
        s[kt] = (f32x4){0.f, 0.f, 0.f, 0.f};
        LAS unsigned char* kp = Kl + ((k0 + 16 * kt + l15) ^ flip) * KVS + quad * 16;
#pragma unroll
        for (int ks = 0; ks < 4; ++ks) { const bf16x8 kf = *(const LAS bf16x8*)(kp + ks * 64); s[kt] = mfma16(kf, qf[ks], s[kt]); }
    }
    float m = -INFINITY;
#pragma unroll
    for (int kt = 0; kt < NT; ++kt)
#pragma unroll
        for (int r = 0; r < 4; ++r) {
            if (DIL) {
                const int j = k0 + 16 * kt + 4 * quad + r; bool valid = true;
                if (kt == 0) valid = valid && (j >= qi);
                if (kt == NT - 1) valid = valid && (j <= qi + 128);
                if (noprev) valid = valid && (j >= 128);
                if (kt == 0 || kt == NT - 1 || noprev) s[kt][r] = valid ? s[kt][r] : -INFINITY; }
            m = fmaxf(m, s[kt][r]);
        }
    m = fmaxf(m, __shfl_xor(m, 16)); m = fmaxf(m, __shfl_xor(m, 32));
    float l = 0.f;
#pragma unroll
    for (int kt = 0; kt < NT; ++kt)
#pragma unroll
        for (int r = 0; r < 4; ++r) { const float p = __builtin_amdgcn_exp2f(s[kt][r] - m); l += p; s[kt][r] = p; }
    l += __shfl_xor(l, 16); l += __shfl_xor(l, 32);
#pragma unroll
    for (int dt = 0; dt < 8; ++dt) o[dt] = (f32x4){0.f, 0.f, 0.f, 0.f};
    constexpr int NP = (NT + 1) / 2;
#pragma unroll
    for (int pp = 0; pp < NP; ++pp) {
        u32x4 pw; pw.x = pk2(s[2 * pp][0], s[2 * pp][1]); pw.y = pk2(s[2 * pp][2], s[2 * pp][3]);
        if (2 * pp + 1 < NT) { pw.z = pk2(s[(2 * pp + 1 < NT) ? 2 * pp + 1 : 0][0], s[(2 * pp + 1 < NT) ? 2 * pp + 1 : 0][1]); pw.w = pk2(s[(2 * pp + 1 < NT) ? 2 * pp + 1 : 0][2], s[(2 * pp + 1 < NT) ? 2 * pp + 1 : 0][3]); }
        else { pw.z = 0u; pw.w = 0u; }
        const bf16x8 pf = __builtin_bit_cast(bf16x8, pw);
        LAS unsigned char* vlo = Vl + ((k0 + 32 * pp + 4 * quad + (l15 >> 2)) ^ flip) * KVS + (l15 & 3) * 8;
        LAS unsigned char* vhi = (2 * pp + 1 < NT) ? Vl + ((k0 + 32 * pp + 16 + 4 * quad + (l15 >> 2)) ^ flip) * KVS + (l15 & 3) * 8 : vlo;
#pragma unroll
        for (int dt = 0; dt < 8; ++dt) {
            const s16x4 lo = __builtin_amdgcn_ds_read_tr16_b64_v4i16((LAS s16x4*)(vlo + dt * 32));
            const s16x4 hi = __builtin_amdgcn_ds_read_tr16_b64_v4i16((LAS s16x4*)(vhi + dt * 32));
            const bf16x8 vf = __builtin_shufflevector(lo, hi, 0, 1, 2, 3, 4, 5, 6, 7);
            o[dt] = mfma16(vf, pf, o[dt]);
        }
    }
    m_out = m; l_out = l;
}

DI void rot_cs(int pos, double f2pi, float& cs, float& sn) {
    const double rev = (double)pos * f2pi; const float fr = (float)(rev - __builtin_floor(rev));
    cs = __builtin_amdgcn_cosf(fr); sn = __builtin_amdgcn_sinf(fr);
}
#define ROTF(i) ((i) == 0 ? 0.15915494309189535 : (i) == 1 ? 0.0700865215877985 : (i) == 2 ? 0.03086376340470123 : (i) == 3 ? 0.013591370636193905 : \
                 (i) == 4 ? 0.005985185712713705 : (i) == 5 ? 0.002635675898667414 : (i) == 6 ? 0.001160663641240061 : (i) == 7 ? 0.0005111175045375439 : \
                 (i) == 8 ? 0.00022507907903927653 : (i) == 9 ? 9.911730936901935e-05 : (i) == 10 ? 4.364795279280289e-05 : (i) == 11 ? 1.9221100684944863e-05 : \
                 (i) == 12 ? 8.464330808241401e-06 : (i) == 13 ? 3.727408601915352e-06 : (i) == 14 ? 1.6414262627950345e-06 : 7.228293068832865e-07)

__device__ const double kRotF[16] = {0.15915494309189535, 0.0700865215877985, 0.03086376340470123, 0.013591370636193905, 0.005985185712713705, 0.002635675898667414, 0.001160663641240061, 0.0005111175045375439,
                                     0.00022507907903927653, 9.911730936901935e-05, 4.364795279280289e-05, 1.9221100684944863e-05, 8.464330808241401e-06, 3.727408601915352e-06, 1.6414262627950345e-06, 7.228293068832865e-07};
DI void dil_chain(LAS unsigned char* lds, bf16_t* cols, float* lse, const float* rot, const float* qgain, const float* kgain, int w, int grp) {
    const int tid = launder_tid(), lane = tid & 63, wave = tid >> 6, l15 = lane & 15, quad = lane >> 4;
    int g, bl, h, r, c0, nblk;
    if (w < 256)      { g = 0; bl = w >> 5; h = (w >> 2) & 7; r = 0; c0 = (w & 3) * 4; nblk = 4; }
    else if (w < 512) { const int q = w - 256; g = 1; bl = q >> 5; h = (q >> 2) & 7; r = q & 3; c0 = 0; nblk = 4; }
    else              { const int q = w - 512; g = 2; bl = q >> 7; h = (q >> 4) & 7; r = q & 15; c0 = 0; nblk = 1; }
    const int d = 1 << (2 * g);
    const int bglob = grp * 8 + bl;
    const int qoff = g * 1024 + h * 128, koff = 3072 + qoff, voff = 6144 + qoff;
    LAS unsigned char* Kl = lds; LAS unsigned char* Vl = lds + 256 * KVS;
    const GAS float* qg = launder_g(qgain + g * 128); const GAS float* kg = launder_g(kgain + g * 128); const GAS float* rotg = launder_g(rot);
    const bf16_t* bbase = cols + (size_t)bl * SEQ * IN_A;
    const int srow = tid >> 2, sq = tid & 3;
    const int i0 = wave * 16, qi = i0 + l15;
    u32x4 kr[4], vr[4], qr[4];
#define DIL_LOAD(cc) do { const int p_ = ((cc) * 128 + srow) * d + r; const bf16_t* rp_ = bbase + (size_t)p_ * IN_A; \
        _Pragma("unroll") for (int e_ = 0; e_ < 4; ++e_) { kr[e_] = *(const u32x4*)(rp_ + koff + sq * 32 + e_ * 8); vr[e_] = *(const u32x4*)(rp_ + voff + sq * 32 + e_ * 8); } } while (0)
#define DIL_LOADQ(cc) do { const int p_ = ((cc) * 128 + qi) * d + r; const bf16_t* rp_ = bbase + (size_t)p_ * IN_A + qoff; \
        _Pragma("unroll") for (int ks_ = 0; ks_ < 4; ++ks_) qr[ks_] = *(const u32x4*)(rp_ + ks_ * 32 + quad * 8); } while (0)
#define DIL_STAGE(cc) do { const int row_ = ((cc) & 1) * 128 + srow; LAS unsigned char* dK_ = Kl + row_ * KVS + sq * 64; LAS unsigned char* dV_ = Vl + row_ * KVS + sq * 64; \
        _Pragma("unroll") for (int e_ = 0; e_ < 4; ++e_) *(LAS u32x4*)(dV_ + e_ * 16) = vr[e_]; \
        float kf_[32]; float ss_ = 0.f; \
        _Pragma("unroll") for (int e_ = 0; e_ < 4; ++e_) _Pragma("unroll") for (int w_ = 0; w_ < 4; ++w_) { kf_[e_ * 8 + 2 * w_] = bflo(kr[e_][w_]); kf_[e_ * 8 + 2 * w_ + 1] = bfhi(kr[e_][w_]); } \
        _Pragma("unroll") for (int e_ = 0; e_ < 32; ++e_) ss_ += kf_[e_] * kf_[e_]; \
        ss_ += __shfl_xor(ss_, 1); ss_ += __shfl_xor(ss_, 2); \
        const float rstd_ = rsqrtf(ss_ * (1.f / 128.f) + EPS); \
        const GAS f32x4* gp_ = (const GAS f32x4*)(kg + sq * 32); \
        _Pragma("unroll") for (int e_ = 0; e_ < 8; ++e_) { const f32x4 gv_ = gp_[e_]; kf_[4 * e_] *= rstd_ * gv_[0]; kf_[4 * e_ + 1] *= rstd_ * gv_[1]; kf_[4 * e_ + 2] *= rstd_ * gv_[2]; kf_[4 * e_ + 3] *= rstd_ * gv_[3]; } \
        if (sq == 0) { const GAS f32x4* rt_ = (const GAS f32x4*)(rotg + (size_t)(bglob * SEQ + ((cc) * 128 + srow) * d + r) * 32); \
            _Pragma("unroll") for (int q4_ = 0; q4_ < 4; ++q4_) { const f32x4 cs4_ = rt_[q4_], sn4_ = rt_[4 + q4_]; \
                _Pragma("unroll") for (int u_ = 0; u_ < 4; ++u_) { const int q_ = 4 * q4_ + u_; const float x1_ = kf_[q_], x2_ = kf_[16 + q_]; kf_[q_] = x1_ * cs4_[u_] - x2_ * sn4_[u_]; kf_[16 + q_] = x2_ * cs4_[u_] + x1_ * sn4_[u_]; } } } \
        _Pragma("unroll") for (int e_ = 0; e_ < 4; ++e_) { u32x4 w_; w_.x = pk2(kf_[8 * e_], kf_[8 * e_ + 1]); w_.y = pk2(kf_[8 * e_ + 2], kf_[8 * e_ + 3]); w_.z = pk2(kf_[8 * e_ + 4], kf_[8 * e_ + 5]); w_.w = pk2(kf_[8 * e_ + 6], kf_[8 * e_ + 7]); \
            *(LAS u32x4*)(dK_ + e_ * 16) = w_; } } while (0)
    __syncthreads();
    if (c0 > 0) { DIL_LOAD(c0 - 1); DIL_STAGE(c0 - 1); }
    else { const int row_ = 128 + srow; const u32x4 z = (u32x4){0u, 0u, 0u, 0u};
#pragma unroll
        for (int e = 0; e < 4; ++e) { *(LAS u32x4*)(Kl + row_ * KVS + sq * 64 + e * 16) = z; *(LAS u32x4*)(Vl + row_ * KVS + sq * 64 + e * 16) = z; } }
    DIL_LOAD(c0); DIL_LOADQ(c0);
    for (int c = c0; c < c0 + nblk; ++c) {
        if (c > c0) __syncthreads();
        DIL_STAGE(c);
        const int p = (c * 128 + qi) * d + r;
        bf16_t* qrow = cols + (size_t)(bl * SEQ + p) * IN_A + qoff;
        bf16x8 qf[4];
        const bool lead = wave < 4;
        if (lead) {
        {
            float qv[4][8]; float ss = 0.f;
#pragma unroll
            for (int ks = 0; ks < 4; ++ks) { const u32x4 wq = qr[ks];
                qv[ks][0] = bflo(wq.x); qv[ks][1] = bfhi(wq.x); qv[ks][2] = bflo(wq.y); qv[ks][3] = bfhi(wq.y); qv[ks][4] = bflo(wq.z); qv[ks][5] = bfhi(wq.z); qv[ks][6] = bflo(wq.w); qv[ks][7] = bfhi(wq.w); }
#pragma unroll
            for (int ks = 0; ks < 4; ++ks)
#pragma unroll
                for (int e = 0; e < 8; ++e) ss += qv[ks][e] * qv[ks][e];
            ss += __shfl_xor(ss, 16); ss += __shfl_xor(ss, 32);
            const float rstd = rsqrtf(ss * (1.f / 128.f) + EPS) * QSCALE;
#pragma unroll
            for (int ks = 0; ks < 4; ++ks) { const f32x4 g0 = *(const GAS f32x4*)(qg + ks * 32 + quad * 8), g1 = *(const GAS f32x4*)(qg + ks * 32 + quad * 8 + 4);
                qv[ks][0] *= rstd * g0[0]; qv[ks][1] *= rstd * g0[1]; qv[ks][2] *= rstd * g0[2]; qv[ks][3] *= rstd * g0[3];
                qv[ks][4] *= rstd * g1[0]; qv[ks][5] *= rstd * g1[1]; qv[ks][6] *= rstd * g1[2]; qv[ks][7] *= rstd * g1[3]; }
            const GAS float* rt = rotg + (size_t)(bglob * SEQ + p) * 32 + (quad & 1) * 8;
            const f32x4 c0 = *(const GAS f32x4*)rt, c1 = *(const GAS f32x4*)(rt + 4), s0 = *(const GAS f32x4*)(rt + 16), s1 = *(const GAS f32x4*)(rt + 20);
            const bool second = quad >= 2;
#pragma unroll
            for (int e = 0; e < 8; ++e) {
                const float cs = e < 4 ? c0[e & 3] : c1[e & 3], sn = e < 4 ? s0[e & 3] : s1[e & 3];
                const float mine = qv[0][e], other = __shfl_xor(mine, 32);
                qv[0][e] = second ? (mine * cs + other * sn) : (mine * cs - other * sn);
            }
#pragma unroll
            for (int ks = 0; ks < 4; ++ks) { u32x4 wq; wq.x = pk2(qv[ks][0], qv[ks][1]); wq.y = pk2(qv[ks][2], qv[ks][3]); wq.z = pk2(qv[ks][4], qv[ks][5]); wq.w = pk2(qv[ks][6], qv[ks][7]); qf[ks] = __builtin_bit_cast(bf16x8, wq); }
        }
            if (c + 1 < c0 + nblk) { DIL_LOAD(c + 1); DIL_LOADQ(c + 1); }
        }
        __syncthreads();
        if (!lead) {
        {
            float qv[4][8]; float ss = 0.f;
#pragma unroll
            for (int ks = 0; ks < 4; ++ks) { const u32x4 wq = qr[ks];
                qv[ks][0] = bflo(wq.x); qv[ks][1] = bfhi(wq.x); qv[ks][2] = bflo(wq.y); qv[ks][3] = bfhi(wq.y); qv[ks][4] = bflo(wq.z); qv[ks][5] = bfhi(wq.z); qv[ks][6] = bflo(wq.w); qv[ks][7] = bfhi(wq.w); }
#pragma unroll
            for (int ks = 0; ks < 4; ++ks)
#pragma unroll
                for (int e = 0; e < 8; ++e) ss += qv[ks][e] * qv[ks][e];
            ss += __shfl_xor(ss, 16); ss += __shfl_xor(ss, 32);
            const float rstd = rsqrtf(ss * (1.f / 128.f) + EPS) * QSCALE;
#pragma unroll
            for (int ks = 0; ks < 4; ++ks) { const f32x4 g0 = *(const GAS f32x4*)(qg + ks * 32 + quad * 8), g1 = *(const GAS f32x4*)(qg + ks * 32 + quad * 8 + 4);
                qv[ks][0] *= rstd * g0[0]; qv[ks][1] *= rstd * g0[1]; qv[ks][2] *= rstd * g0[2]; qv[ks][3] *= rstd * g0[3];
                qv[ks][4] *= rstd * g1[0]; qv[ks][5] *= rstd * g1[1]; qv[ks][6] *= rstd * g1[2]; qv[ks][7] *= rstd * g1[3]; }
            const GAS float* rt = rotg + (size_t)(bglob * SEQ + p) * 32 + (quad & 1) * 8;
            const f32x4 c0 = *(const GAS f32x4*)rt, c1 = *(const GAS f32x4*)(rt + 4), s0 = *(const GAS f32x4*)(rt + 16), s1 = *(const GAS f32x4*)(rt + 20);
            const bool second = quad >= 2;
#pragma unroll
            for (int e = 0; e < 8; ++e) {
                const float cs = e < 4 ? c0[e & 3] : c1[e & 3], sn = e < 4 ? s0[e & 3] : s1[e & 3];
                const float mine = qv[0][e], other = __shfl_xor(mine, 32);
                qv[0][e] = second ? (mine * cs + other * sn) : (mine * cs - other * sn);
            }
#pragma unroll
            for (int ks = 0; ks < 4; ++ks) { u32x4 wq; wq.x = pk2(qv[ks][0], qv[ks][1]); wq.y = pk2(qv[ks][2], qv[ks][3]); wq.z = pk2(qv[ks][4], qv[ks][5]); wq.w = pk2(qv[ks][6], qv[ks][7]); qf[ks] = __builtin_bit_cast(bf16x8, wq); }
        }
            if (c + 1 < c0 + nblk) { DIL_LOAD(c + 1); DIL_LOADQ(c + 1); }
        }
        f32x4 o[8]; float m, l;
        attn_core<9, true>(Kl, Vl, qf, i0, qi, c == 0, (c & 1) ? 0 : 128, o, m, l);
        const float inv = 1.f / l;
#pragma unroll
        for (int dt = 0; dt < 8; dt += 2) {
            u32x2 w0, w1; w0.x = pk2(o[dt][0] * inv, o[dt][1] * inv); w0.y = pk2(o[dt][2] * inv, o[dt][3] * inv); w1.x = pk2(o[dt + 1][0] * inv, o[dt + 1][1] * inv); w1.y = pk2(o[dt + 1][2] * inv, o[dt + 1][3] * inv);
            *(u32x4*)(qrow + (dt + (quad & 1)) * 16 + (quad >> 1) * 8) = swap16_pack(w0, w1); }
        if (quad == 0) lse[(size_t)(bl * SEQ + p) * 24 + g * 8 + h] = (m + __log2f(l)) * LN2;
    }
#undef DIL_LOAD
#undef DIL_LOADQ
#undef DIL_STAGE
}

DI void mem_attn_unit(LAS unsigned char* lds, bf16_t* cols, int ldc, int qmoff, int gmoff, const bf16_t* kvm, int lay, const float* qgain, const float* kgain, int unit, int bbase, int nq) {
    const int tid = launder_tid(), lane = tid & 63, wave = tid >> 6, l15 = lane & 15, quad = lane >> 4;
    const int nsub = 16 / nq, qsub = unit % nsub, bh = unit / nsub, h = bh & 3, bl = bh >> 2;
    const GAS float* qgg = launder_g(qgain); const GAS float* kgg = launder_g(kgain); const GAS bf16_t* kvmg = launder_g(kvm);
    const int bglob = bbase + bl;
    LAS unsigned char* Kl = lds; LAS unsigned char* Vl = lds + 256 * KVS;
    __syncthreads();
    {
        const int j = tid >> 1, half = tid & 1;
        LAS unsigned char* dK = Kl + j * KVS + half * 128; LAS unsigned char* dV = Vl + j * KVS + half * 128;
        const GAS bf16_t* rowp = kvmg + (size_t)(bglob * 256 + j) * 4096 + lay * 1024 + h * 128 + half * 64;
        const GAS u32x4* ks = (const GAS u32x4*)rowp; const GAS u32x4* vs = (const GAS u32x4*)(rowp + 512);
        u32x4 kr[8], vr[8];
#pragma unroll
        for (int e = 0; e < 8; ++e) { kr[e] = ks[e]; vr[e] = vs[e]; }
#pragma unroll
        for (int e = 0; e < 8; ++e) *(LAS u32x4*)(dV + e * 16) = vr[e];
        float ss = 0.f;
#pragma unroll
        for (int e = 0; e < 8; ++e)
#pragma unroll
            for (int w = 0; w < 4; ++w) { const float a = bflo(kr[e][w]), b = bfhi(kr[e][w]); ss += a * a + b * b; }
        ss += __shfl_xor(ss, 1);
        const float rstd = rsqrtf(ss * (1.f / 128.f) + EPS);
        const GAS f32x4* gp = (const GAS f32x4*)(kgg + half * 64);
#pragma unroll
        for (int e = 0; e < 8; ++e) {
            const f32x4 g0 = gp[2 * e], g1 = gp[2 * e + 1];
            u32x4 w;
            w.x = pk2(bflo(kr[e].x) * rstd * g0[0], bfhi(kr[e].x) * rstd * g0[1]); w.y = pk2(bflo(kr[e].y) * rstd * g0[2], bfhi(kr[e].y) * rstd * g0[3]);
            w.z = pk2(bflo(kr[e].z) * rstd * g1[0], bfhi(kr[e].z) * rstd * g1[1]); w.w = pk2(bflo(kr[e].w) * rstd * g1[2], bfhi(kr[e].w) * rstd * g1[3]);
            *(LAS u32x4*)(dK + e * 16) = w;
        }
    }
    u32x4 qr[4];
#define MEM_LOADQ(qt_) do { const bf16_t* qp_ = cols + (size_t)(bl * SEQ + (qt_) * 128 + wave * 16 + l15) * ldc + qmoff + h * 128; \
        _Pragma("unroll") for (int ks_ = 0; ks_ < 4; ++ks_) qr[ks_] = *(const u32x4*)(qp_ + ks_ * 32 + quad * 8); } while (0)
    MEM_LOADQ(qsub * nq);
    __syncthreads();
    for (int qq = 0; qq < nq; ++qq) {
        const int qt = qsub * nq + qq;
        const int p = qt * 128 + wave * 16 + l15;
        bf16_t* rowp = cols + (size_t)(bl * SEQ + p) * ldc;
        bf16x8 qf[4];
        {
            float qv[4][8]; float ss = 0.f;
#pragma unroll
            for (int ks = 0; ks < 4; ++ks) { const u32x4 w = qr[ks];
                qv[ks][0] = bflo(w.x); qv[ks][1] = bfhi(w.x); qv[ks][2] = bflo(w.y); qv[ks][3] = bfhi(w.y); qv[ks][4] = bflo(w.z); qv[ks][5] = bfhi(w.z); qv[ks][6] = bflo(w.w); qv[ks][7] = bfhi(w.w); }
#pragma unroll
            for (int ks = 0; ks < 4; ++ks)
#pragma unroll
                for (int e = 0; e < 8; ++e) ss += qv[ks][e] * qv[ks][e];
            ss += __shfl_xor(ss, 16); ss += __shfl_xor(ss, 32);
            const float rstd = rsqrtf(ss * (1.f / 128.f) + EPS) * QSCALE;
#pragma unroll
            for (int ks = 0; ks < 4; ++ks) { const f32x4 g0 = *(const GAS f32x4*)(qgg + ks * 32 + quad * 8), g1 = *(const GAS f32x4*)(qgg + ks * 32 + quad * 8 + 4);
                u32x4 w; w.x = pk2(qv[ks][0] * rstd * g0[0], qv[ks][1] * rstd * g0[1]); w.y = pk2(qv[ks][2] * rstd * g0[2], qv[ks][3] * rstd * g0[3]);
                w.z = pk2(qv[ks][4] * rstd * g1[0], qv[ks][5] * rstd * g1[1]); w.w = pk2(qv[ks][6] * rstd * g1[2], qv[ks][7] * rstd * g1[3]); qf[ks] = __builtin_bit_cast(bf16x8, w); }
        }
        if (qq + 1 < nq) MEM_LOADQ(qt + 1);
        bf16_t* grow = rowp + gmoff + h * 128;
        u32x4 gwv[4];
#pragma unroll
        for (int dp = 0; dp < 4; ++dp) gwv[dp] = *(const u32x4*)(grow + (2 * dp + (quad & 1)) * 16 + (quad >> 1) * 8);
        f32x4 o[8]; float m, l;
        attn_core<16, false>(Kl, Vl, qf, 0, 0, false, 0, o, m, l);
        const float inv = 1.f / l;
#pragma unroll
        for (int dp = 0; dp < 4; ++dp) {
            const int dt = 2 * dp;
            u32x2 w0, w1; w0.x = pk2(o[dt][0] * inv, o[dt][1] * inv); w0.y = pk2(o[dt][2] * inv, o[dt][3] * inv); w1.x = pk2(o[dt + 1][0] * inv, o[dt + 1][1] * inv); w1.y = pk2(o[dt + 1][2] * inv, o[dt + 1][3] * inv);
            const u32x4 ov = swap16_pack(w0, w1), gw = gwv[dp];
            u32x4 y;
#pragma unroll
            for (int e = 0; e < 4; ++e) y[e] = pk2(bflo(ov[e]) * silu(bflo(gw[e])), bfhi(ov[e]) * silu(bfhi(gw[e])));
            *(u32x4*)(grow + (dt + (quad & 1)) * 16 + (quad >> 1) * 8) = y;
        }
    }
#undef MEM_LOADQ
}

DI void gla_item(LAS unsigned char* lds, bf16_t* cols, const float* lb, int item) {
    const int tid = launder_tid(), lane = tid & 63, wave = tid >> 6, l15 = lane & 15, quad = lane >> 4;
    const int vh = item & 1, h = (item >> 1) & 7, b = item >> 4;
    LAS unsigned char* RQ = lds; LAS unsigned char* RF = RQ + 16384; LAS unsigned char* QT = RF + 16384; LAS unsigned char* KT = QT + 17408; LAS unsigned char* QG = KT + 17408;
    LAS unsigned char* KD = QG + 17408; LAS unsigned char* VT = KD + 18432; LAS unsigned char* AT = VT + 9216; LAS unsigned char* ST = AT + 9216; LAS unsigned char* GL = ST + 17408; LAS unsigned char* SEG = GL + 512;
    bf16_t* base = cols + (size_t)b * SEQ * IN_B;
    const int qcol = h * 128, fcol = 1024 + h * 128, vcol = 2048 + h * 128 + vh * 64;
    const int ek = tid & 127, eseg = tid >> 7;
    const GAS float* lbg = launder_g(lb);
    const float lbk = lbg[h * 128 + ek], omlb = 1.f - lbk;
    f32x4 sacc[4];
#pragma unroll
    for (int i = 0; i < 4; ++i) sacc[i] = (f32x4){0.f, 0.f, 0.f, 0.f};
    __syncthreads();
    for (int i = tid; i < 17408 / 16; i += NTHREADS) ((LAS u32x4*)ST)[i] = (u32x4){0u, 0u, 0u, 0u};
    const int lrow = tid >> 3, lc16 = tid & 7, vt_t = tid & 63, vt_v8 = tid >> 6;
    u32x4 pq0, pq1, pf0, pf1, pv;
#define GLA_LOAD(cc) do { const bf16_t* rp = base + (size_t)((cc) * 64 + lrow) * IN_B; \
        pq0 = *(const u32x4*)(rp + qcol + lc16 * 8); pq1 = *(const u32x4*)(rp + qcol + 64 + lc16 * 8); \
        pf0 = *(const u32x4*)(rp + fcol + lc16 * 8); pf1 = *(const u32x4*)(rp + fcol + 64 + lc16 * 8); \
        pv = *(const u32x4*)(base + (size_t)((cc) * 64 + vt_t) * IN_B + vcol + vt_v8 * 8); } while (0)
#define GLA_STORE() do { *(LAS u32x4*)(RQ + lrow * 256 + lc16 * 16) = pq0; *(LAS u32x4*)(RQ + lrow * 256 + 128 + lc16 * 16) = pq1; \
        *(LAS u32x4*)(RF + lrow * 256 + lc16 * 16) = pf0; *(LAS u32x4*)(RF + lrow * 256 + 128 + lc16 * 16) = pf1; \
        LAS bf16_t* vt = (LAS bf16_t*)VT + (vt_v8 * 8) * 72 + vt_t; \
        vt[0 * 72] = (bf16_t)(pv.x & 0xffffu); vt[1 * 72] = (bf16_t)(pv.x >> 16); vt[2 * 72] = (bf16_t)(pv.y & 0xffffu); vt[3 * 72] = (bf16_t)(pv.y >> 16); \
        vt[4 * 72] = (bf16_t)(pv.z & 0xffffu); vt[5 * 72] = (bf16_t)(pv.z >> 16); vt[6 * 72] = (bf16_t)(pv.w & 0xffffu); vt[7 * 72] = (bf16_t)(pv.w >> 16); } while (0)
    GLA_LOAD(0); GLA_STORE();
    for (int c = 0; c < 32; ++c) {
        __syncthreads();
        if (c + 1 < 32) GLA_LOAD(c + 1);
        float cp[16], kk[16], qq[16]; float run = 1.f;
#pragma unroll
        for (int tt = 0; tt < 16; ++tt) { const int t = eseg * 16 + tt;
            const float z = bf2f(((LAS bf16_t*)RF)[t * 128 + ek]);
            const float sg = __builtin_amdgcn_rcpf(1.f + __expf(-z)); const float fg = lbk + omlb * sg;
            run *= fg; cp[tt] = run; kk[tt] = 1.f - fg; qq[tt] = bf2f(((LAS bf16_t*)RQ)[t * 128 + ek]); }
        ((LAS float*)SEG)[eseg * 128 + ek] = run;
        __syncthreads();
        const float s0 = ((LAS float*)SEG)[ek], s1 = ((LAS float*)SEG)[128 + ek], s2 = ((LAS float*)SEG)[256 + ek], s3 = ((LAS float*)SEG)[384 + ek];
        const float pmid = s0 * s1, ptail = s2 * s3;
        const float e1s = (eseg == 0) ? __builtin_amdgcn_rcpf(s0) * __builtin_amdgcn_rcpf(s1) : (eseg == 1) ? __builtin_amdgcn_rcpf(s1) : (eseg == 2) ? 1.f : s2;
        if (eseg == 0) ((LAS float*)GL)[ek] = pmid * ptail;
        unsigned kdp[8];
#pragma unroll
        for (int tt = 0; tt < 16; tt += 2) {
            float kd2[2];
#pragma unroll
            for (int u = 0; u < 2; ++u) { const int t = eseg * 16 + tt + u;
                const float e1 = cp[tt + u] * e1s, r1 = __builtin_amdgcn_rcpf(e1);
                ((LAS bf16_t*)QG)[t * 136 + ek] = f2bf(qq[tt + u] * e1 * pmid);
                ((LAS bf16_t*)QT)[t * 136 + ek] = f2bf(qq[tt + u] * e1);
                ((LAS bf16_t*)KT)[t * 136 + ek] = f2bf(kk[tt + u] * r1);
                kd2[u] = kk[tt + u] * (ptail * r1); }
            kdp[tt >> 1] = pk2(kd2[0], kd2[1]);
        }
        *(LAS u32x4*)(KD + ek * 144 + eseg * 32) = (u32x4){kdp[0], kdp[1], kdp[2], kdp[3]};
        *(LAS u32x4*)(KD + ek * 144 + eseg * 32 + 16) = (u32x4){kdp[4], kdp[5], kdp[6], kdp[7]};
        __syncthreads();
        const int tt_ = wave >> 1;
        {
            bf16x8 bq[4];
#pragma unroll
            for (int ks = 0; ks < 4; ++ks) bq[ks] = *(const LAS bf16x8*)(QT + (16 * tt_ + l15) * 272 + ks * 64 + quad * 16);
#pragma unroll
            for (int u = 0; u < 2; ++u) { const int st = 2 * (wave & 1) + u;
                f32x4 a = (f32x4){0.f, 0.f, 0.f, 0.f};
                if (st <= tt_) {
#pragma unroll
                    for (int ks = 0; ks < 4; ++ks) { const bf16x8 ka = *(const LAS bf16x8*)(KT + (16 * st + l15) * 272 + ks * 64 + quad * 16); a = mfma16(ka, bq[ks], a); }
                }
                const int tq = 16 * tt_ + l15, sb = 16 * st + 4 * quad;
                const float a0 = (st <= tt_ && sb + 0 <= tq) ? a[0] : 0.f, a1 = (st <= tt_ && sb + 1 <= tq) ? a[1] : 0.f, a2 = (st <= tt_ && sb + 2 <= tq) ? a[2] : 0.f, a3 = (st <= tt_ && sb + 3 <= tq) ? a[3] : 0.f;
                u32x2 w; w.x = pk2(a0, a1); w.y = pk2(a2, a3);
                *(LAS u32x2*)(AT + tq * 144 + sb * 2) = w; }
        }
        __syncthreads();
        {
            bf16x8 bq[4], ba[2];
#pragma unroll
            for (int ks = 0; ks < 4; ++ks) bq[ks] = *(const LAS bf16x8*)(QG + (16 * tt_ + l15) * 272 + ks * 64 + quad * 16);
#pragma unroll
            for (int ks = 0; ks < 2; ++ks) ba[ks] = *(const LAS bf16x8*)(AT + (16 * tt_ + l15) * 144 + ks * 64 + quad * 16);
#pragma unroll
            for (int u = 0; u < 2; ++u) { const int vt = 2 * (wave & 1) + u;
                f32x4 a = (f32x4){0.f, 0.f, 0.f, 0.f};
#pragma unroll
                for (int ks = 0; ks < 4; ++ks) { const bf16x8 sa = *(const LAS bf16x8*)(ST + (16 * vt + l15) * 272 + ks * 64 + quad * 16); a = mfma16(sa, bq[ks], a); }
#pragma unroll
                for (int ks = 0; ks < 2; ++ks) { const bf16x8 va = *(const LAS bf16x8*)(VT + (16 * vt + l15) * 144 + ks * 64 + quad * 16); a = mfma16(va, ba[ks], a); }
                u32x2 w; w.x = pk2(a[0], a[1]); w.y = pk2(a[2], a[3]);
                *(u32x2*)(base + (size_t)(c * 64 + 16 * tt_ + l15) * IN_B + vcol + 16 * vt + 4 * quad) = w; }
        }
        {
            bf16x8 ka[2];
#pragma unroll
            for (int ks = 0; ks < 2; ++ks) ka[ks] = *(const LAS bf16x8*)(KD + (16 * wave + l15) * 144 + ks * 64 + quad * 16);
            const f32x4 gl = *(const LAS f32x4*)(GL + (16 * wave + 4 * quad) * 4);
#pragma unroll
            for (int vt = 0; vt < 4; ++vt) { sacc[vt] = sacc[vt] * gl;
#pragma unroll
                for (int ks = 0; ks < 2; ++ks) { const bf16x8 vb = *(const LAS bf16x8*)(VT + (16 * vt + l15) * 144 + ks * 64 + quad * 16); sacc[vt] = mfma16(ka[ks], vb, sacc[vt]); } }
        }
        __syncthreads();
#pragma unroll
        for (int vt = 0; vt < 4; ++vt) { u32x2 w; w.x = pk2(sacc[vt][0], sacc[vt][1]); w.y = pk2(sacc[vt][2], sacc[vt][3]);
            *(LAS u32x2*)(ST + (16 * vt + l15) * 272 + (16 * wave + 4 * quad) * 2) = w; }
        if (c + 1 < 32) GLA_STORE();
    }
#undef GLA_LOAD
#undef GLA_STORE
}

DI void gate_A(bf16_t* cols, const float* lse, int ntok, int bid, int nb) {
    const int tid = launder_tid(), sub = tid & 127, h = sub >> 4, d8 = (sub & 15) * 8;
    constexpr int U = 4;
    for (int tok0 = bid * 4 + (tid >> 7); tok0 < ntok; tok0 += nb * 4 * U) {
        u32x4 o0[U], o1[U], o2[U], gt[U]; float l0[U], l1[U], l2[U];
#pragma unroll
        for (int u = 0; u < U; ++u) { const int tok = min(tok0 + u * nb * 4, ntok - 1); const bf16_t* rowp = cols + (size_t)tok * IN_A;
            l0[u] = lse[(size_t)tok * 24 + h]; l1[u] = lse[(size_t)tok * 24 + 8 + h]; l2[u] = lse[(size_t)tok * 24 + 16 + h];
            o0[u] = *(const u32x4*)(rowp + h * 128 + d8); o1[u] = *(const u32x4*)(rowp + 1024 + h * 128 + d8); o2[u] = *(const u32x4*)(rowp + 2048 + h * 128 + d8);
            gt[u] = *(const u32x4*)(rowp + 9728 + h * 128 + d8); }
#pragma unroll
        for (int u = 0; u < U; ++u) { const int tok = tok0 + u * nb * 4; if (tok >= ntok) continue;
            const float m = fmaxf(l0[u], fmaxf(l1[u], l2[u]));
            float w0 = __expf(l0[u] - m), w1 = __expf(l1[u] - m), w2 = __expf(l2[u] - m);
            const float inv = 1.f / (w0 + w1 + w2); w0 *= inv; w1 *= inv; w2 *= inv;
            u32x4 y;
#pragma unroll
            for (int e = 0; e < 4; ++e) {
                const float ylo = (w0 * bflo(o0[u][e]) + w1 * bflo(o1[u][e]) + w2 * bflo(o2[u][e])) * silu(bflo(gt[u][e]));
                const float yhi = (w0 * bfhi(o0[u][e]) + w1 * bfhi(o1[u][e]) + w2 * bfhi(o2[u][e])) * silu(bfhi(gt[u][e]));
                y[e] = pk2(ylo, yhi); }
            *(u32x4*)(cols + (size_t)tok * IN_A + 9728 + h * 128 + d8) = y; }
    }
}
DI void gate_B(bf16_t* cols, const float* ogain, int ntok, int bid, int nb) {
    const int tid = launder_tid(), sub = tid & 127, h = sub >> 4, d8 = (sub & 15) * 8;
    const GAS float* ogg = launder_g(ogain);
    const f32x4 g0 = *(const GAS f32x4*)(ogg + d8), g1 = *(const GAS f32x4*)(ogg + d8 + 4);
    constexpr int U = 4;
    for (int tok0 = bid * 4 + (tid >> 7); tok0 < ntok; tok0 += nb * 4 * U) {
        u32x4 ow[U], gt[U];
#pragma unroll
        for (int u = 0; u < U; ++u) { const bf16_t* rowp = cols + (size_t)(tok0 + u * nb * 4) * IN_B;
            ow[u] = *(const u32x4*)(rowp + 2048 + h * 128 + d8); gt[u] = *(const u32x4*)(rowp + 3584 + h * 128 + d8); }
#pragma unroll
        for (int u = 0; u < U; ++u) {
            float ov[8]; float ss = 0.f;
#pragma unroll
            for (int e = 0; e < 4; ++e) { ov[2 * e] = bflo(ow[u][e]); ov[2 * e + 1] = bfhi(ow[u][e]); }
#pragma unroll
            for (int e = 0; e < 8; ++e) ss += ov[e] * ov[e];
            ss += __shfl_xor(ss, 1); ss += __shfl_xor(ss, 2); ss += __shfl_xor(ss, 4); ss += __shfl_xor(ss, 8);
            const float rstd = rsqrtf(ss * (1.f / 128.f) + EPS);
            u32x4 y;
            y[0] = pk2(ov[0] * rstd * g0[0] * silu(bflo(gt[u][0])), ov[1] * rstd * g0[1] * silu(bfhi(gt[u][0])));
            y[1] = pk2(ov[2] * rstd * g0[2] * silu(bflo(gt[u][1])), ov[3] * rstd * g0[3] * silu(bfhi(gt[u][1])));
            y[2] = pk2(ov[4] * rstd * g1[0] * silu(bflo(gt[u][2])), ov[5] * rstd * g1[1] * silu(bfhi(gt[u][2])));
            y[3] = pk2(ov[6] * rstd * g1[2] * silu(bflo(gt[u][3])), ov[7] * rstd * g1[3] * silu(bfhi(gt[u][3])));
            *(u32x4*)(cols + (size_t)(tok0 + u * nb * 4) * IN_B + 3584 + h * 128 + d8) = y; }
    }
}

constexpr int NSTEPS = 26;
__device__ const unsigned char kSteps[NSTEPS][4] = {
    {0, 0, 0, 0}, {1, 0, 0, 0},
    {2, 0, 0, 0}, {3, 0, 0, 0}, {4, 0, 0, 0}, {5, 0, 0, 0}, {2, 0, 1, 0}, {3, 0, 1, 0}, {4, 0, 1, 1}, {5, 0, 1, 0},
    {2, 1, 0, 0}, {3, 1, 0, 0}, {4, 1, 0, 1}, {5, 1, 0, 0},
    {2, 2, 0, 0}, {3, 2, 0, 0}, {4, 2, 0, 0}, {5, 2, 0, 0}, {2, 2, 1, 0}, {3, 2, 1, 0}, {4, 2, 1, 1}, {5, 2, 1, 0},
    {2, 3, 0, 0}, {3, 3, 0, 0}, {4, 3, 0, 0}, {5, 3, 0, 0}};

__global__ void __launch_bounds__(NTHREADS, 2) fwd_megakernel(Params P) {
    extern __shared__ __attribute__((aligned(16))) unsigned char lds_raw[];
    LAS unsigned char* lds = (LAS unsigned char*)lds_raw;
    cg::grid_group grid = cg::this_grid();
    const int bid = blockIdx.x, nb = gridDim.x, tid = threadIdx.x;
    unsigned char* ws = P.ws;
    const float* x_in = P.in[0]; const float* mem = P.in[1]; const int* positions = (const int*)P.in[2];
    const float* norm_gain = P.in[3]; const float* w_in_a = P.in[4]; const float* q_gain_a = P.in[5]; const float* k_gain_a = P.in[6]; const float* w_out_a = P.in[7];
    const float* w_in_b = P.in[8]; const float* lb_logits = P.in[9]; const float* o_gain_b = P.in[10]; const float* w_out_b = P.in[11];
    const float* mem_norm_gain = P.in[12]; const float* w_mem_kv = P.in[13]; const float* mem_q_gain = P.in[14]; const float* mem_k_gain = P.in[15];
    bf16_t* WinT = (bf16_t*)(ws + WS_WIN); bf16_t* WoutT = (bf16_t*)(ws + WS_WOUT); bf16_t* XN = (bf16_t*)(ws + WS_XN); bf16_t* KVM = (bf16_t*)(ws + WS_KVM);
    bf16_t* MEMN = (bf16_t*)(ws + WS_MEMN); bf16_t* WkvT = (bf16_t*)(ws + WS_WKV); float* LSE = (float*)(ws + WS_LSE); float* LB = (float*)(ws + WS_LB); bf16_t* COLS = (bf16_t*)(ws + WS_COLS);
    float* ROT = (float*)(ws + WS_ROT);
    float* SSQ = (float*)(ws + WS_SSQ); bf16_t* WoutT2 = (bf16_t*)(ws + WS_WOUT2);
    float* out = P.out;
    volatile LAS unsigned* bst = (volatile LAS unsigned*)(lds + LDS_BYTES - 16);
    if (tid < 4) bst[tid] = 0u;
    __syncthreads();
    const XcdBarrier xbar = xcd_barrier_post((unsigned*)(ws + WS_BAR), bst);

    for (int step = 0; step < NSTEPS; ++step) {
        const int op = kSteps[step][0], l = kSteps[step][1], grp = kSteps[step][2];
        const int j = l >> 1; const bool isA = (l & 1) == 0;
        if (op == 0) {
            convert_wT(lds, w_in_a, norm_gain, WinT, DM, IN_A, bid, nb);
            convert_wT(lds, w_out_a, nullptr, WoutT, MIXW, DM, bid, nb);
            prep_rows(x_in, XN, SSQ, T_TOK, bid, nb);
            for (int q = 0; q < 4; ++q) convert_wT(lds, w_mem_kv + (size_t)q * DM * 1024, mem_norm_gain + q * DM, WkvT + (size_t)q * 1024 * DM, DM, 1024, bid, nb);
            norm_rows(mem, MEMN, 4096, bid, nb);
            {
                for (int e = bid * NTHREADS + launder_tid(); e < T_TOK * 16; e += nb * NTHREADS) {
                    const int tok = e >> 4, i = e & 15; float cs, sn; rot_cs(positions[tok], kRotF[i], cs, sn);
                    ROT[(size_t)tok * 32 + i] = cs; ROT[(size_t)tok * 32 + 16 + i] = sn; }
                for (int c = bid * NTHREADS + launder_tid(); c < 1024; c += nb * NTHREADS) {
                    const float a0 = lb_logits[c], a1 = lb_logits[1024 + c], a2 = lb_logits[2048 + c], a3 = lb_logits[3072 + c];
                    const float m = fmaxf(fmaxf(a0, a1), fmaxf(a2, a3));
                    const float e0 = __expf(a0 - m), e1 = __expf(a1 - m), e2 = __expf(a2 - m), e3 = __expf(a3 - m), inv = 1.f / (e0 + e1 + e2 + e3);
                    LB[c] = e1 * inv; LB[1024 + c] = (e1 + e2 + e3) * inv;
                }
            }
        } else if (op == 1 || op == 2 || op == 5) {
            pg8::Gemm g; pg8::Epi E; E.O = nullptr; E.ldc = 0; E.ssq_in = nullptr; E.X = nullptr; E.C = nullptr; E.ssq_out = nullptr;
            if (op == 1)      { g.A = MEMN; g.Bt = WkvT; g.M = 4096; g.N = 4096; g.K = DM; g.lda = DM; E.mode = 0; E.O = KVM; E.ldc = 4096; }
            else if (op == 2) { const int ldc = isA ? IN_A : IN_B; g.A = XN + (size_t)grp * 16384 * DM; g.Bt = WinT; g.M = isA ? 16384 : T_TOK; g.N = ldc; g.K = DM; g.lda = DM; E.mode = 0; E.O = COLS; E.ldc = ldc;
                                E.ssq_in = SSQ + (size_t)grp * 16384 * 16; }
            else              { const int ldc = isA ? IN_A : IN_B; g.A = COLS + (isA ? 9728 : 3584); g.Bt = (l & 1) ? WoutT2 : WoutT; g.M = isA ? 16384 : T_TOK; g.N = DM; g.K = MIXW; g.lda = ldc; E.mode = 1;
                                E.X = XN + (size_t)grp * 16384 * DM;
                                if (l == 3) E.C = out + (size_t)grp * 16384 * DM; else E.ssq_out = SSQ + (size_t)grp * 16384 * 16; }
            pg8::StaticOrder S; S.init(g.M, g.N, nb, bid);
            pg8::gemm_phase(lds, g, S, E);
        } else if (op == 3) {
            if (isA) { for (int it = bid; it < 1536; it += nb) dil_chain(lds, COLS, LSE, ROT, q_gain_a + j * 384, k_gain_a + j * 384, it, grp); }
            else     { for (int it = bid; it < 256; it += nb) gla_item(lds, COLS, LB + j * 1024, it); }
            const int ldc = isA ? IN_A : IN_B, qmoff = isA ? 9216 : 3072, gmoff = isA ? (9728 + 1024) : (3584 + 1024), nq = isA ? 2 : 4;
            for (int it = bid; it < 256; it += nb) mem_attn_unit(lds, COLS, ldc, qmoff, gmoff, KVM, l, mem_q_gain + l * 128, mem_k_gain + l * 128, it, grp * 8, nq);
        } else {
            if (isA) gate_A(COLS, LSE, 16384, bid, nb); else gate_B(COLS, o_gain_b + j * 128, T_TOK, bid, nb);
            if (kSteps[step][3]) {
                const int l1 = l + 1, j1 = l1 >> 1; const bool a1 = (l1 & 1) == 0;
                const float* win = a1 ? w_in_a + (size_t)j1 * DM * IN_A : w_in_b + (size_t)j1 * DM * IN_B;
                const float* wout = a1 ? w_out_a + (size_t)j1 * MIXW * DM : w_out_b + (size_t)j1 * MIXW * DM;
                convert_wT(lds, win, norm_gain + l1 * DM, WinT, DM, a1 ? IN_A : IN_B, bid, nb);
                convert_wT(lds, wout, nullptr, (l1 & 1) ? WoutT2 : WoutT, MIXW, DM, bid, nb);
            }
        }
        if (op == 1) continue;
        if (nb > (1 << 20)) grid.sync();
        xcd_barrier(xbar);
    }
}

extern "C" void kernel_launch(void* const* d_in, const int* in_sizes, int n_in, void* d_out, int out_size, void* d_ws, size_t ws_size, hipStream_t stream) {
    static int grid_blocks = 0;
    if (grid_blocks == 0) {
        if (n_in != 16 || out_size != T_TOK * DM || ws_size < WS_END) { fprintf(stderr, "kernel_launch: unexpected shapes (n_in %d out %d ws %zu need %zu)\n", n_in, out_size, ws_size, (size_t)WS_END); grid_blocks = -1; return; }
        int dev = 0, cus = 0, per_cu = 0;
        (void)hipGetDevice(&dev);
        (void)hipDeviceGetAttribute(&cus, hipDeviceAttributeMultiprocessorCount, dev);
        if (hipFuncSetAttribute((const void*)fwd_megakernel, hipFuncAttributeMaxDynamicSharedMemorySize, LDS_BYTES) != hipSuccess) { fprintf(stderr, "kernel_launch: hipFuncSetAttribute failed\n"); grid_blocks = -1; return; }
        (void)hipOccupancyMaxActiveBlocksPerMultiprocessor(&per_cu, (const void*)fwd_megakernel, NTHREADS, LDS_BYTES);
        if (per_cu < 1) per_cu = 1;
        grid_blocks = cus * per_cu;
        (void)hipGetLastError();
    }
    if (grid_blocks < 0) return;
    if (hipMemsetAsync((char*)d_ws + WS_BAR, 0, XCD_BAR_WORDS * 4, stream) != hipSuccess) { fprintf(stderr, "kernel_launch: memset of barrier words failed\n"); return; }
    Params p{};
    for (int i = 0; i < 16; ++i) p.in[i] = (const float*)d_in[i];
    p.out = (float*)d_out; p.ws = (unsigned char*)d_ws;
    void* args[] = {&p};
    hipError_t e = hipLaunchCooperativeKernel((const void*)fwd_megakernel, dim3(grid_blocks), dim3(NTHREADS), args, LDS_BYTES, stream);
    if (e != hipSuccess) fprintf(stderr, "cooperative launch failed: %s (grid %d)\n", hipGetErrorString(e), grid_blocks);
}
```

```cpp
#include <hip/hip_runtime.h>
#include <hip/hip_cooperative_groups.h>
#include <cstdio>
namespace cg = cooperative_groups;

#define DI __device__ __forceinline__
#define LAS __attribute__((address_space(3)))
typedef unsigned short bf16_t;
typedef short bf16x8 __attribute__((ext_vector_type(8)));
typedef short s16x4 __attribute__((ext_vector_type(4)));
typedef float f32x4 __attribute__((ext_vector_type(4)));
typedef unsigned u32x4 __attribute__((ext_vector_type(4)));
typedef unsigned u32x2 __attribute__((ext_vector_type(2)));

constexpr int T_TOK = 32768, DM = 1024, SEQ = 2048;
constexpr int IN_A = 11264, IN_B = 5120, MIXW = 1536;
constexpr int NTHREADS = 512;
constexpr int LDS_BYTES = 149504;
constexpr int SSQ_LDS_OFF = 131072;
constexpr float EPS = 1e-6f;
constexpr float QSCALE = 0.12751743082459868f;
constexpr float LN2 = 0.6931471805599453f;

constexpr size_t WS_WIN  = 0;
constexpr size_t WS_WOUT = WS_WIN + (size_t)IN_A * DM * 2;
constexpr size_t WS_XN   = WS_WOUT + (size_t)DM * MIXW * 2;
constexpr size_t WS_KVM  = WS_XN + (size_t)T_TOK * DM * 2;
constexpr size_t WS_MEMN = WS_KVM + (size_t)4096 * 4096 * 2;
constexpr size_t WS_WKV  = WS_MEMN + (size_t)4096 * 1024 * 2;
constexpr size_t WS_LSE  = WS_WKV + (size_t)4096 * 1024 * 2;
constexpr size_t WS_LB   = WS_LSE + (size_t)16384 * 24 * 4;
constexpr size_t WS_COLS = WS_LB + 8192;
constexpr size_t WS_BAR  = WS_COLS + (size_t)16384 * IN_A * 2;
constexpr size_t WS_ROT  = WS_BAR + 16384;
constexpr size_t WS_SSQ  = WS_ROT + (size_t)T_TOK * 32 * 4;
constexpr size_t WS_WOUT2 = WS_SSQ + (size_t)T_TOK * 16 * 4;
constexpr size_t WS_END  = WS_WOUT2 + (size_t)DM * MIXW * 2;

struct Params { const float* in[16]; float* out; unsigned char* ws; };

#define GAS __attribute__((address_space(1)))
template <class T> DI const GAS T* launder_g(const T* p) { asm volatile("" : "+s"(p)); return (const GAS T*)p; }
DI int launder_tid() { int t = threadIdx.x; asm volatile("" : "+v"(t)); return t; }
DI float bf2f(unsigned short h) { return __uint_as_float(((unsigned)h) << 16); }
DI float bflo(unsigned u) { return __uint_as_float(u << 16); }
DI float bfhi(unsigned u) { return __uint_as_float(u & 0xffff0000u); }
typedef __bf16 bf16x2_t __attribute__((ext_vector_type(2)));
typedef float f32x2_t __attribute__((ext_vector_type(2)));
DI unsigned pk2(float lo, float hi) { const f32x2_t v = {lo, hi}; const bf16x2_t b = __builtin_convertvector(v, bf16x2_t); return __builtin_bit_cast(unsigned, b); }
DI unsigned short f2bf(float x) { return (unsigned short)(pk2(x, x) & 0xffffu); }
DI u32x4 swap16_pack(u32x2 a, u32x2 b) {
    const u32x2 X = __builtin_amdgcn_permlane16_swap(a.x, b.x, false, false);
    const u32x2 Y = __builtin_amdgcn_permlane16_swap(a.y, b.y, false, false);
    return (u32x4){X.x, Y.x, X.y, Y.y};
}
DI float silu(float g) { return g / (1.f + __expf(-g)); }
DI f32x4 mfma16(bf16x8 a, bf16x8 b, f32x4 c) { return __builtin_amdgcn_mfma_f32_16x16x32_bf16(a, b, c, 0, 0, 0); }


#define XB_TMO      128
#define XB_XCNT(j)  (256  + 64 * (j))
#define XB_XSUB(j)  (1280 + 64 * (j))
#define XB_XGEN(j)  (2304 + 64 * (j))
#define XB_TOP      3328
#define XB_TOPGEN   3392
#define XCD_BAR_WORDS 3456
#define XB_SPIN_CAP (1u << 18)
DI unsigned xb_ld(unsigned* p)              { return __hip_atomic_load(p, __ATOMIC_RELAXED, __HIP_MEMORY_SCOPE_AGENT); }
DI unsigned xb_add(unsigned* p, unsigned v) { return __hip_atomic_fetch_add(p, v, __ATOMIC_RELAXED, __HIP_MEMORY_SCOPE_AGENT); }
DI unsigned xb_xcc_id() { return (unsigned)__builtin_amdgcn_s_getreg((3 << 11) | 20) & 0xFu; }
#define XB_SPIN(cond, bar) do { unsigned _sp = 0; while (cond) { __builtin_amdgcn_s_sleep(1); \
    if ((++_sp & 255u) == 0u) { if (xb_ld(&(bar)[XB_TMO])) break; if (_sp > XB_SPIN_CAP) { atomicAdd(&(bar)[XB_TMO], 1u); break; } } } } while (0)
struct XcdBarrier { unsigned* bar; unsigned x; volatile LAS unsigned* st; };
DI XcdBarrier xcd_barrier_post(unsigned* bar, volatile LAS unsigned* st) {
    XcdBarrier b; b.bar = bar; b.x = xb_xcc_id(); b.st = st;
    if (threadIdx.x == 0) (void)xb_add(&bar[XB_XCNT(b.x)], 1u);
    return b;
}
DI void xcd_barrier_complete(unsigned* bar, unsigned x, unsigned& nloc, unsigned& nx) {
    const unsigned G = gridDim.x * gridDim.y * gridDim.z;
    unsigned sum, cnt, mine, sp = 0u;
    for (;;) {
        sum = 0u; cnt = 0u; mine = 0u;
#pragma unroll
        for (unsigned j = 0; j < 16; ++j) { const unsigned c = xb_ld(&bar[XB_XCNT(j)]); sum += c; cnt += (c > 0u) ? 1u : 0u; mine = (j == x) ? c : mine; }
        if (sum == G) break;
        __builtin_amdgcn_s_sleep(1);
        if ((++sp & 255u) == 0u) { if (xb_ld(&bar[XB_TMO])) break; if (sp > XB_SPIN_CAP) { atomicAdd(&bar[XB_TMO], 1u); break; } }
    }
    nloc = mine > 0u ? mine : 1u; nx = cnt > 0u ? cnt : 1u;
}
DI void xcd_barrier(const XcdBarrier& b) {
    asm volatile("s_waitcnt vmcnt(0)" ::: "memory");
    __syncthreads();
    if (threadIdx.x == 0) {
        unsigned* bar = b.bar;
        __builtin_amdgcn_s_waitcnt(0);
        unsigned nloc = b.st[0], nx = b.st[1];
        if (nloc == 0u) { xcd_barrier_complete(bar, b.x, nloc, nx); b.st[0] = nloc; b.st[1] = nx; }
        const unsigned old = xb_add(&bar[XB_XSUB(b.x)], 1u);
        const unsigned gen = old / nloc;
        if (old + 1u == (gen + 1u) * nloc) {
            __builtin_amdgcn_fence(__ATOMIC_RELEASE, "agent");
            asm volatile("s_waitcnt vmcnt(0)" ::: "memory");
            const unsigned og = xb_add(&bar[XB_TOP], 1u);
            const unsigned tg = og / nx;
            if (og + 1u == (tg + 1u) * nx) xb_add(&bar[XB_TOPGEN], 1u);
            else XB_SPIN(xb_ld(&bar[XB_TOPGEN]) == tg, bar);
            __builtin_amdgcn_fence(__ATOMIC_ACQUIRE, "agent");
            xb_add(&bar[XB_XGEN(b.x)], 1u);
            asm volatile("s_waitcnt vmcnt(0)" ::: "memory");
        } else {
            XB_SPIN(xb_ld(&bar[XB_XGEN(b.x)]) == gen, bar);
            __builtin_amdgcn_fence(__ATOMIC_ACQUIRE, "agent");
            asm volatile("s_waitcnt vmcnt(0)" ::: "memory");
        }
    }
    __syncthreads();
}

namespace pg8 {
constexpr int BM = 256, BK = 64, HALF = 128, HTB = HALF * BK * 2, STAGE_BYTES = 8 * HTB, NXCD = 8, WGM = 8;
DI int lds_byte(int r, int c) { const int st = (r >> 4) * 2 + (c >> 5), rr = r & 15, cc = c & 31, ob = rr * 64 + cc * 2; return st * 1024 + (ob ^ (((ob >> 9) & 1) << 5)); }
DI void stage_rc(int b, int& R, int& C) { const int st = b / 1024, sb = b % 1024, swz = sb ^ (((sb >> 9) & 1) << 5); R = (st >> 1) * 16 + swz / 64; C = (st & 1) * 32 + (swz % 64) / 2; }
DI int perm32(int rho) { const int n = rho >> 4, i = rho & 15; return 8 * (i >> 2) + 4 * n + (i & 3); }
struct Unit { int pm, pn; };
struct Gemm { const bf16_t* A; const bf16_t* Bt; int M, N, K, lda; };
struct StaticOrder {
    int nM, nN, nwg, G, c;
    DI void init(int M, int N, int G_, int c_) { nM = M / BM; nN = N / BM; nwg = nM * nN; G = G_; c = c_; }
    DI bool next(int i, Unit& u) const {
        const long L = (long)i * G + c; if (L >= nwg) return false;
        int wgid = (int)L; { const int q = nwg / NXCD, r = nwg % NXCD, xcd = wgid % NXCD, off = wgid / NXCD; wgid = (xcd < r ? xcd * (q + 1) : r * (q + 1) + (xcd - r) * q) + off; }
        const int nig = WGM * nN, gid = wgid / nig, fm = gid * WGM, gsz = (nM - fm) < WGM ? (nM - fm) : WGM;
        u.pm = fm + ((wgid % nig) % gsz); u.pn = (wgid % nig) / gsz; return true;
    }
};
struct Epi {
    int mode; bf16_t* O; int ldc;
    const float* ssq_in;
    bf16_t* X;
    float* C;
    float* ssq_out;
    DI void operator()(const f32x4 (&acc)[2][2][4][2], const Unit& u, int wr, int wc, int fr, int fq, LAS unsigned char* lds) const {
        if (mode == 0) {
            const int row0 = u.pm * BM + wr * 64 + fr, col0 = u.pn * BM + wc * 32 + 8 * fq;
            float rs[2][4];
#pragma unroll
            for (int ai = 0; ai < 2; ++ai)
#pragma unroll
                for (int m = 0; m < 4; ++m) rs[ai][m] = 1.f;
            if (ssq_in) {
                f32x4 pp[2][4];
#pragma unroll
                for (int ai = 0; ai < 2; ++ai)
#pragma unroll
                    for (int m = 0; m < 4; ++m) pp[ai][m] = *(const LAS f32x4*)(lds + SSQ_LDS_OFF + (wr * 64 + fr + ai * HALF + m * 16) * 64 + fq * 16);
#pragma unroll
                for (int ai = 0; ai < 2; ++ai)
#pragma unroll
                    for (int m = 0; m < 4; ++m) { float s = (pp[ai][m][0] + pp[ai][m][1]) + (pp[ai][m][2] + pp[ai][m][3]); s += __shfl_xor(s, 16); s += __shfl_xor(s, 32); rs[ai][m] = rsqrtf(s * (1.f / DM) + EPS); }
            }
            const __amdgpu_buffer_rsrc_t orsrc = __builtin_amdgcn_make_buffer_rsrc((void*)O, (short)0, 0x7fffffff, 0x00020000);
#pragma unroll
            for (int ai = 0; ai < 2; ++ai)
#pragma unroll
                for (int m = 0; m < 4; ++m) { const unsigned ro = (unsigned)(((size_t)(row0 + ai * HALF + m * 16) * ldc + col0) * 2);
#pragma unroll
                    for (int bj = 0; bj < 2; ++bj) { const f32x4 v0 = acc[ai][bj][m][0] * rs[ai][m], v1 = acc[ai][bj][m][1] * rs[ai][m];
                        u32x4 w; w.x = pk2(v0[0], v0[1]); w.y = pk2(v0[2], v0[3]); w.z = pk2(v1[0], v1[1]); w.w = pk2(v1[2], v1[3]);
                        __builtin_amdgcn_raw_buffer_store_b128(w, orsrc, ro + bj * HALF * 2, 0, 16); } }
        } else {
            const int row0 = u.pm * BM + wr * 64 + fr, col0 = u.pn * BM + wc * 32 + 8 * fq;
#pragma unroll
            for (int ai = 0; ai < 2; ++ai) {
                u32x4 rb[4][2];
#pragma unroll
                for (int m = 0; m < 4; ++m)
#pragma unroll
                    for (int bj = 0; bj < 2; ++bj) rb[m][bj] = *(const u32x4*)(X + (size_t)(row0 + ai * HALF + m * 16) * DM + col0 + bj * HALF);
#pragma unroll
                for (int m = 0; m < 4; ++m) {
                    const size_t ro = (size_t)(row0 + ai * HALF + m * 16) * DM + col0;
                    float ssp = 0.f;
#pragma unroll
                    for (int bj = 0; bj < 2; ++bj) { const u32x4 r = rb[m][bj];
                        f32x4 v0 = acc[ai][bj][m][0], v1 = acc[ai][bj][m][1];
                        v0[0] += bflo(r.x); v0[1] += bfhi(r.x); v0[2] += bflo(r.y); v0[3] += bfhi(r.y); v1[0] += bflo(r.z); v1[1] += bfhi(r.z); v1[2] += bflo(r.w); v1[3] += bfhi(r.w);
                        if (C) { *(f32x4*)(C + ro + bj * HALF) = v0; *(f32x4*)(C + ro + bj * HALF + 4) = v1; }
                        else { u32x4 w; w.x = pk2(v0[0], v0[1]); w.y = pk2(v0[2], v0[3]); w.z = pk2(v1[0], v1[1]); w.w = pk2(v1[2], v1[3]); *(u32x4*)(X + ro + bj * HALF) = w;
                            const float b0 = bflo(w.x), b1 = bfhi(w.x), b2 = bflo(w.y), b3 = bfhi(w.y), b4 = bflo(w.z), b5 = bfhi(w.z), b6 = bflo(w.w), b7 = bfhi(w.w);
                            ssp += ((b0 * b0 + b1 * b1) + (b2 * b2 + b3 * b3)) + ((b4 * b4 + b5 * b5) + (b6 * b6 + b7 * b7)); } }
                    if (!C) { ssp += __shfl_xor(ssp, 16); ssp += __shfl_xor(ssp, 32);
                        if (fq == 0) ssq_out[(size_t)(row0 + ai * HALF + m * 16) * 16 + u.pn * 4 + wc] = ssp; }
                }
            }
        }
    }
};

DI void gemm_phase(LAS unsigned char* lds, const Gemm g, const StaticOrder& S, const Epi& E) {
    const int tid = launder_tid(), wid = __builtin_amdgcn_readfirstlane(tid >> 6), lane = tid & 63, wr = wid >> 2, wc = wid & 3, fr = lane & 15, fq = lane >> 4;
    const int K = g.K, nt = K / BK, lda = g.lda;
    unsigned voffA[2], voffB[2];
#pragma unroll
    for (int i = 0; i < 2; ++i) { int R, C; stage_rc(tid * 16 + i * 8192, R, C); const int Rb = (R & ~31) + perm32(R & 31);
        voffA[i] = (unsigned)(R * lda + C) * 2u; voffB[i] = (unsigned)(Rb * K + C) * 2u; }
    const size_t kstep = (size_t)(BK * 2);
    const size_t hstepA = (size_t)HALF * lda * 2, hstepB = (size_t)HALF * K * 2;
    const size_t tstepA = 2 * hstepA, tstepB = 2 * hstepB;
    const unsigned ldsw = (unsigned)wid * 1024u;
    const int aoff = lds_byte(wr * 64 + fr, fq * 8), boff = lds_byte(wc * 32 + fr, fq * 8);
#define PG8_SA(b, h) (((b) * 2 + (h)) * HTB)
#define PG8_SB(b, h) ((4 + (b) * 2 + (h)) * HTB)
#define PG8_STAGE(bufoff, gbase, voff) do { _Pragma("unroll") for (int _i = 0; _i < 2; ++_i) \
        __builtin_amdgcn_global_load_lds((const unsigned*)((const char*)(gbase) + (voff)[_i]), (LAS unsigned*)(lds + (bufoff) + ldsw + _i * 8192), 16, 0, 0); } while (0)
#define PG8_LDA(dst, b, h) do { _Pragma("unroll") for (int m = 0; m < 4; ++m) _Pragma("unroll") for (int k = 0; k < 2; ++k) dst[m][k] = *(const LAS bf16x8*)(lds + PG8_SA(b, h) + aoff + m * 2048 + k * 1024); } while (0)
#define PG8_LDB(dst, b, h) do { _Pragma("unroll") for (int n = 0; n < 2; ++n) _Pragma("unroll") for (int k = 0; k < 2; ++k) dst[n][k] = *(const LAS bf16x8*)(lds + PG8_SB(b, h) + boff + n * 2048 + k * 1024); } while (0)
#define PG8_MMA(ai, bj, At, Bt) do { __builtin_amdgcn_s_setprio(1); _Pragma("unroll") for (int m = 0; m < 4; ++m) _Pragma("unroll") for (int n = 0; n < 2; ++n) _Pragma("unroll") for (int k = 0; k < 2; ++k) \
        acc[ai][bj][m][n] = __builtin_amdgcn_mfma_f32_16x16x32_bf16(Bt[n][k], At[m][k], acc[ai][bj][m][n], 0, 0, 0); __builtin_amdgcn_s_setprio(0); } while (0)
#define PG8_WAIT_V(n) asm volatile("s_waitcnt vmcnt(" #n ")" ::: "memory")
#define PG8_WAIT_L(n) asm volatile("s_waitcnt lgkmcnt(" #n ")" ::: "memory")
#define PG8_BAR __builtin_amdgcn_s_barrier()
#define PG8_SCHED __builtin_amdgcn_sched_barrier(0)
    Unit cur, nxt; int ui = 0;
    if (!S.next(0, cur)) return;
    f32x4 acc[2][2][4][2];
#pragma unroll
    for (int a = 0; a < 2; ++a)
#pragma unroll
        for (int b = 0; b < 2; ++b)
#pragma unroll
            for (int m = 0; m < 4; ++m)
#pragma unroll
                for (int n = 0; n < 2; ++n) acc[a][b][m][n] = (f32x4){0.f, 0.f, 0.f, 0.f};
    bf16x8 At[4][2], B0[2][2], B1[2][2];
    const char* cA = (const char*)g.A + (size_t)cur.pm * tstepA; const char* cB = (const char*)g.Bt + (size_t)cur.pn * tstepB;
    PG8_STAGE(PG8_SB(0, 0), cB, voffB); PG8_STAGE(PG8_SB(0, 1), cB + hstepB, voffB); PG8_STAGE(PG8_SA(0, 0), cA, voffA); PG8_STAGE(PG8_SA(0, 1), cA + hstepA, voffA);
    if (wr == 1) PG8_BAR;
    PG8_WAIT_V(2); PG8_BAR;
    PG8_STAGE(PG8_SB(1, 0), cB + kstep, voffB); PG8_STAGE(PG8_SA(1, 0), cA + kstep, voffA); PG8_STAGE(PG8_SB(1, 1), cB + hstepB + kstep, voffB);
    PG8_WAIT_V(6); PG8_BAR;
    for (;;) {
        const bool has_next = S.next(ui + 1, nxt);
        const char* nA = has_next ? (const char*)g.A + (size_t)nxt.pm * tstepA : cA; const char* nB = has_next ? (const char*)g.Bt + (size_t)nxt.pn * tstepB : cB;
        for (int t = 0; t < nt; t += 2) {
            const bool last = (t == nt - 2);
            const char* a1 = cA + (size_t)(t + 1) * kstep;
            const char* a2 = last ? nA : cA + (size_t)(t + 2) * kstep; const char* b2 = last ? nB : cB + (size_t)(t + 2) * kstep;
            const char* a3 = a2 + kstep; const char* b3 = b2 + kstep;
            if (last && E.ssq_in) {
                const char* sp = (const char*)(E.ssq_in + (size_t)cur.pm * BM * 16) + (size_t)wid * 2048 + (size_t)lane * 16;
                __builtin_amdgcn_global_load_lds((const unsigned*)sp, (LAS unsigned*)(lds + SSQ_LDS_OFF + wid * 2048), 16, 0, 0);
                __builtin_amdgcn_global_load_lds((const unsigned*)(sp + 1024), (LAS unsigned*)(lds + SSQ_LDS_OFF + wid * 2048 + 1024), 16, 0, 0);
                __builtin_amdgcn_sched_barrier(0);
            }
            PG8_LDB(B0, 0, 0); PG8_LDB(B1, 0, 1); PG8_SCHED; PG8_LDA(At, 0, 0); PG8_STAGE(PG8_SA(1, 1), a1 + hstepA, voffA);
            PG8_WAIT_V(8); PG8_WAIT_L(0); PG8_BAR; PG8_MMA(0, 0, At, B0); PG8_MMA(0, 1, At, B1); PG8_BAR; PG8_SCHED;
            PG8_LDA(At, 0, 1); PG8_STAGE(PG8_SB(0, 0), b2, voffB); PG8_STAGE(PG8_SB(0, 1), b2 + hstepB, voffB); PG8_STAGE(PG8_SA(0, 0), a2, voffA);
            PG8_WAIT_V(8); PG8_WAIT_L(0); PG8_BAR; PG8_MMA(1, 0, At, B0); PG8_MMA(1, 1, At, B1); PG8_BAR; PG8_SCHED;
            PG8_LDB(B0, 1, 0); PG8_LDB(B1, 1, 1); PG8_SCHED; PG8_LDA(At, 1, 0); PG8_STAGE(PG8_SA(0, 1), a2 + hstepA, voffA);
            PG8_WAIT_V(8); PG8_WAIT_L(0); PG8_BAR; PG8_MMA(0, 0, At, B0); PG8_MMA(0, 1, At, B1); PG8_BAR; PG8_SCHED;
            PG8_LDA(At, 1, 1); PG8_STAGE(PG8_SB(1, 0), b3, voffB); PG8_STAGE(PG8_SB(1, 1), b3 + hstepB, voffB); PG8_STAGE(PG8_SA(1, 0), a3, voffA);
            PG8_WAIT_V(8); PG8_WAIT_L(0); PG8_BAR; PG8_MMA(1, 0, At, B0); PG8_MMA(1, 1, At, B1); PG8_BAR; PG8_SCHED;
        }
        if (wr == 0) PG8_BAR;
        E(acc, cur, wr, wc, fr, fq, lds);
        if (!has_next) break;
#pragma unroll
        for (int a = 0; a < 2; ++a)
#pragma unroll
            for (int b = 0; b < 2; ++b)
#pragma unroll
                for (int m = 0; m < 4; ++m)
#pragma unroll
                    for (int n = 0; n < 2; ++n) acc[a][b][m][n] = (f32x4){0.f, 0.f, 0.f, 0.f};
        cur = nxt; cA = nA; cB = nB; ++ui;
        if (wr == 1) PG8_BAR;
    }
    PG8_WAIT_V(0);
    PG8_BAR;
#undef PG8_SA
#undef PG8_SB
#undef PG8_STAGE
#undef PG8_LDA
#undef PG8_LDB
#undef PG8_MMA
#undef PG8_WAIT_V
#undef PG8_WAIT_L
#undef PG8_BAR
#undef PG8_SCHED
}
}

DI void convert_wT(LAS unsigned char* lds, const float* W, const float* gain, bf16_t* Wt, int K, int N, int bid, int nb) {
    LAS bf16_t* tile = (LAS bf16_t*)lds;
    const int tid = launder_tid();
    const int ntn = N / 64, ntiles = (K / 64) * ntn;
    const int kk = tid >> 3, c8 = (tid & 7) * 8;
    f32x4 a, b; float g = 1.f;
    if (bid < ntiles) { const int k0 = (bid / ntn) * 64, n0 = (bid % ntn) * 64; const float* src = W + (size_t)(k0 + kk) * N + n0 + c8; a = *(const f32x4*)src; b = *(const f32x4*)(src + 4); g = gain ? gain[k0 + kk] : 1.f; }
    for (int t = bid; t < ntiles; t += nb) {
        const int k0 = (t / ntn) * 64, n0 = (t % ntn) * 64;
        const f32x4 ca = a, cb = b; const float cg = g;
        if (t + nb < ntiles) { const int k1 = ((t + nb) / ntn) * 64, n1 = ((t + nb) % ntn) * 64; const float* src = W + (size_t)(k1 + kk) * N + n1 + c8; a = *(const f32x4*)src; b = *(const f32x4*)(src + 4); g = gain ? gain[k1 + kk] : 1.f; }
        __syncthreads();
        tile[(c8 + 0) * 72 + kk] = f2bf(ca[0] * cg); tile[(c8 + 1) * 72 + kk] = f2bf(ca[1] * cg);
        tile[(c8 + 2) * 72 + kk] = f2bf(ca[2] * cg); tile[(c8 + 3) * 72 + kk] = f2bf(ca[3] * cg);
        tile[(c8 + 4) * 72 + kk] = f2bf(cb[0] * cg); tile[(c8 + 5) * 72 + kk] = f2bf(cb[1] * cg);
        tile[(c8 + 6) * 72 + kk] = f2bf(cb[2] * cg); tile[(c8 + 7) * 72 + kk] = f2bf(cb[3] * cg);
        __syncthreads();
        const int n = tid >> 3, k8 = (tid & 7) * 8;
        const u32x4 v = *(LAS u32x4*)(tile + n * 72 + k8);
        *(u32x4*)(Wt + (size_t)(n0 + n) * K + k0 + k8) = v;
    }
    __syncthreads();
}

DI void norm_rows(const float* x, bf16_t* xn, int nrows, int bid, int nb) {
    const int tid_ = launder_tid(); const int wave = tid_ >> 6, lane = tid_ & 63;
    for (int row0 = (bid * 8 + wave) * 4; row0 < nrows; row0 += nb * 32) {
        f32x4 v[4][4];
#pragma unroll
        for (int r = 0; r < 4; ++r) { const f32x4* src = (const f32x4*)(x + (size_t)(row0 + r) * DM);
#pragma unroll
            for (int i = 0; i < 4; ++i) v[r][i] = src[lane + 64 * i]; }
#pragma unroll
        for (int r = 0; r < 4; ++r) {
            float ss = 0.f;
#pragma unroll
            for (int i = 0; i < 4; ++i) ss += v[r][i][0] * v[r][i][0] + v[r][i][1] * v[r][i][1] + v[r][i][2] * v[r][i][2] + v[r][i][3] * v[r][i][3];
#pragma unroll
            for (int o = 32; o >= 1; o >>= 1) ss += __shfl_xor(ss, o);
            const float rstd = rsqrtf(ss * (1.f / DM) + EPS);
#pragma unroll
            for (int i = 0; i < 4; ++i) { u32x2 w; w.x = pk2(v[r][i][0] * rstd, v[r][i][1] * rstd); w.y = pk2(v[r][i][2] * rstd, v[r][i][3] * rstd);
                *(u32x2*)(xn + (size_t)(row0 + r) * DM + (lane + 64 * i) * 4) = w; }
        }
    }
}

DI void prep_rows(const float* x, bf16_t* xn, float* ssq, int nrows, int bid, int nb) {
    const int tid_ = launder_tid(); const int wave = tid_ >> 6, lane = tid_ & 63;
    for (int row0 = (bid * 8 + wave) * 4; row0 < nrows; row0 += nb * 32) {
        f32x4 v[4][4];
#pragma unroll
        for (int r = 0; r < 4; ++r) { const f32x4* src = (const f32x4*)(x + (size_t)(row0 + r) * DM);
#pragma unroll
            for (int i = 0; i < 4; ++i) v[r][i] = src[lane + 64 * i]; }
#pragma unroll
        for (int r = 0; r < 4; ++r) {
            float ss = 0.f;
#pragma unroll
            for (int i = 0; i < 4; ++i) { u32x2 w; w.x = pk2(v[r][i][0], v[r][i][1]); w.y = pk2(v[r][i][2], v[r][i][3]);
                *(u32x2*)(xn + (size_t)(row0 + r) * DM + (lane + 64 * i) * 4) = w;
                const float b0 = bflo(w.x), b1 = bfhi(w.x), b2 = bflo(w.y), b3 = bfhi(w.y); ss += (b0 * b0 + b1 * b1) + (b2 * b2 + b3 * b3); }
#pragma unroll
            for (int o = 32; o >= 1; o >>= 1) ss += __shfl_xor(ss, o);
            if (lane < 16) ssq[(size_t)(row0 + r) * 16 + lane] = (lane == 0) ? ss : 0.f;
        }
    }
}

constexpr int KVS = 272;
template <int NT, bool DIL>
DI void attn_core(LAS unsigned char* Kl, LAS unsigned char* Vl, const bf16x8 (&qf)[4], int k0, int qi, bool noprev, int flip, f32x4 (&o)[8], float& m_out, float& l_out) {
    const int lane = launder_tid() & 63, l15 = lane & 15, quad = lane >> 4;
    f32x4 s[NT];
#pragma unroll
    for (int kt = 0; kt < NT; ++kt) {
        s[kt] = (f32x4){0.f, 0.f, 0.f, 0.f};
        LAS unsigned char* kp = Kl + ((k0 + 16 * kt + l15) ^ flip) * KVS + quad * 16;
#pragma unroll
        for (int ks = 0; ks < 4; ++ks) { const bf16x8 kf = *(const LAS bf16x8*)(kp + ks * 64); s[kt] = mfma16(kf, qf[ks], s[kt]); }
    }
    float m = -INFINITY;
#pragma unroll
    for (int kt = 0; kt < NT; ++kt)
#pragma unroll
        for (int r = 0; r < 4; ++r) {
            if (DIL) {
                const int j = k0 + 16 * kt + 4 * quad + r; bool valid = true;
                if (kt == 0) valid = valid && (j >= qi);
                if (kt == NT - 1) valid = valid && (j <= qi + 128);
                if (noprev) valid = valid && (j >= 128);
                if (kt == 0 || kt == NT - 1 || noprev) s[kt][r] = valid ? s[kt][r] : -INFINITY; }
            m = fmaxf(m, s[kt][r]);
        }
    m = fmaxf(m, __shfl_xor(m, 16)); m = fmaxf(m, __shfl_xor(m, 32));
    float l = 0.f;
#pragma unroll
    for (int kt = 0; kt < NT; ++kt)
#pragma unroll
        for (int r = 0; r < 4; ++r) { const float p = __builtin_amdgcn_exp2f(s[kt][r] - m); l += p; s[kt][r] = p; }
    l += __shfl_xor(l, 16); l += __shfl_xor(l, 32);
#pragma unroll
    for (int dt = 0; dt < 8; ++dt) o[dt] = (f32x4){0.f, 0.f, 0.f, 0.f};
    constexpr int NP = (NT + 1) / 2;
#pragma unroll
    for (int pp = 0; pp < NP; ++pp) {
        u32x4 pw; pw.x = pk2(s[2 * pp][0], s[2 * pp][1]); pw.y = pk2(s[2 * pp][2], s[2 * pp][3]);
        if (2 * pp + 1 < NT) { pw.z = pk2(s[(2 * pp + 1 < NT) ? 2 * pp + 1 : 0][0], s[(2 * pp + 1 < NT) ? 2 * pp + 1 : 0][1]); pw.w = pk2(s[(2 * pp + 1 < NT) ? 2 * pp + 1 : 0][2], s[(2 * pp + 1 < NT) ? 2 * pp + 1 : 0][3]); }
        else { pw.z = 0u; pw.w = 0u; }
        const bf16x8 pf = __builtin_bit_cast(bf16x8, pw);
        LAS unsigned char* vlo = Vl + ((k0 + 32 * pp + 4 * quad + (l15 >> 2)) ^ flip) * KVS + (l15 & 3) * 8;
        LAS unsigned char* vhi = (2 * pp + 1 < NT) ? Vl + ((k0 + 32 * pp + 16 + 4 * quad + (l15 >> 2)) ^ flip) * KVS + (l15 & 3) * 8 : vlo;
#pragma unroll
        for (int dt = 0; dt < 8; ++dt) {
            const s16x4 lo = __builtin_amdgcn_ds_read_tr16_b64_v4i16((LAS s16x4*)(vlo + dt * 32));
            const s16x4 hi = __builtin_amdgcn_ds_read_tr16_b64_v4i16((LAS s16x4*)(vhi + dt * 32));
            const bf16x8 vf = __builtin_shufflevector(lo, hi, 0, 1, 2, 3, 4, 5, 6, 7);
            o[dt] = mfma16(vf, pf, o[dt]);
        }
    }
    m_out = m; l_out = l;
}

DI void rot_cs(int pos, double f2pi, float& cs, float& sn) {
    const double rev = (double)pos * f2pi; const float fr = (float)(rev - __builtin_floor(rev));
    cs = __builtin_amdgcn_cosf(fr); sn = __builtin_amdgcn_sinf(fr);
}
#define ROTF(i) ((i) == 0 ? 0.15915494309189535 : (i) == 1 ? 0.0700865215877985 : (i) == 2 ? 0.03086376340470123 : (i) == 3 ? 0.013591370636193905 : \
                 (i) == 4 ? 0.005985185712713705 : (i) == 5 ? 0.002635675898667414 : (i) == 6 ? 0.001160663641240061 : (i) == 7 ? 0.0005111175045375439 : \
                 (i) == 8 ? 0.00022507907903927653 : (i) == 9 ? 9.911730936901935e-05 : (i) == 10 ? 4.364795279280289e-05 : (i) == 11 ? 1.9221100684944863e-05 : \
                 (i) == 12 ? 8.464330808241401e-06 : (i) == 13 ? 3.727408601915352e-06 : (i) == 14 ? 1.6414262627950345e-06 : 7.228293068832865e-07)

__device__ const double kRotF[16] = {0.15915494309189535, 0.0700865215877985, 0.03086376340470123, 0.013591370636193905, 0.005985185712713705, 0.002635675898667414, 0.001160663641240061, 0.0005111175045375439,
                                     0.00022507907903927653, 9.911730936901935e-05, 4.364795279280289e-05, 1.9221100684944863e-05, 8.464330808241401e-06, 3.727408601915352e-06, 1.6414262627950345e-06, 7.228293068832865e-07};
DI void dil_chain(LAS unsigned char* lds, bf16_t* cols, float* lse, const float* rot, const float* qgain, const float* kgain, int w, int grp) {
    const int tid = launder_tid(), lane = tid & 63, wave = tid >> 6, l15 = lane & 15, quad = lane >> 4;
    int g, bl, h, r, c0, nblk;
    if (w < 256)      { g = 0; bl = w >> 5; h = (w >> 2) & 7; r = 0; c0 = (w & 3) * 4; nblk = 4; }
    else if (w < 512) { const int q = w - 256; g = 1; bl = q >> 5; h = (q >> 2) & 7; r = q & 3; c0 = 0; nblk = 4; }
    else              { const int q = w - 512; g = 2; bl = q >> 7; h = (q >> 4) & 7; r = q & 15; c0 = 0; nblk = 1; }
    const int d = 1 << (2 * g);
    const int bglob = grp * 8 + bl;
    const int qoff = g * 1024 + h * 128, koff = 3072 + qoff, voff = 6144 + qoff;
    LAS unsigned char* Kl = lds; LAS unsigned char* Vl = lds + 256 * KVS;
    const GAS float* qg = launder_g(qgain + g * 128); const GAS float* kg = launder_g(kgain + g * 128); const GAS float* rotg = launder_g(rot);
    const bf16_t* bbase = cols + (size_t)bl * SEQ * IN_A;
    const int srow = tid >> 2, sq = tid & 3;
    const int i0 = wave * 16, qi = i0 + l15;
    u32x4 kr[4], vr[4], qr[4];
#define DIL_LOAD(cc) do { const int p_ = ((cc) * 128 + srow) * d + r; const bf16_t* rp_ = bbase + (size_t)p_ * IN_A; \
        _Pragma("unroll") for (int e_ = 0; e_ < 4; ++e_) { kr[e_] = *(const u32x4*)(rp_ + koff + sq * 32 + e_ * 8); vr[e_] = *(const u32x4*)(rp_ + voff + sq * 32 + e_ * 8); } } while (0)
#define DIL_LOADQ(cc) do { const int p_ = ((cc) * 128 + qi) * d + r; const bf16_t* rp_ = bbase + (size_t)p_ * IN_A + qoff; \
        _Pragma("unroll") for (int ks_ = 0; ks_ < 4; ++ks_) qr[ks_] = *(const u32x4*)(rp_ + ks_ * 32 + quad * 8); } while (0)
#define DIL_STAGE(cc) do { const int row_ = ((cc) & 1) * 128 + srow; LAS unsigned char* dK_ = Kl + row_ * KVS + sq * 64; LAS unsigned char* dV_ = Vl + row_ * KVS + sq * 64; \
        _Pragma("unroll") for (int e_ = 0; e_ < 4; ++e_) *(LAS u32x4*)(dV_ + e_ * 16) = vr[e_]; \
        float kf_[32]; float ss_ = 0.f; \
        _Pragma("unroll") for (int e_ = 0; e_ < 4; ++e_) _Pragma("unroll") for (int w_ = 0; w_ < 4; ++w_) { kf_[e_ * 8 + 2 * w_] = bflo(kr[e_][w_]); kf_[e_ * 8 + 2 * w_ + 1] = bfhi(kr[e_][w_]); } \
        _Pragma("unroll") for (int e_ = 0; e_ < 32; ++e_) ss_ += kf_[e_] * kf_[e_]; \
        ss_ += __shfl_xor(ss_, 1); ss_ += __shfl_xor(ss_, 2); \
        const float rstd_ = rsqrtf(ss_ * (1.f / 128.f) + EPS); \
        const GAS f32x4* gp_ = (const GAS f32x4*)(kg + sq * 32); \
        _Pragma("unroll") for (int e_ = 0; e_ < 8; ++e_) { const f32x4 gv_ = gp_[e_]; kf_[4 * e_] *= rstd_ * gv_[0]; kf_[4 * e_ + 1] *= rstd_ * gv_[1]; kf_[4 * e_ + 2] *= rstd_ * gv_[2]; kf_[4 * e_ + 3] *= rstd_ * gv_[3]; } \
        if (sq == 0) { const GAS f32x4* rt_ = (const GAS f32x4*)(rotg + (size_t)(bglob * SEQ + ((cc) * 128 + srow) * d + r) * 32); \
            _Pragma("unroll") for (int q4_ = 0; q4_ < 4; ++q4_) { const f32x4 cs4_ = rt_[q4_], sn4_ = rt_[4 + q4_]; \
                _Pragma("unroll") for (int u_ = 0; u_ < 4; ++u_) { const int q_ = 4 * q4_ + u_; const float x1_ = kf_[q_], x2_ = kf_[16 + q_]; kf_[q_] = x1_ * cs4_[u_] - x2_ * sn4_[u_]; kf_[16 + q_] = x2_ * cs4_[u_] + x1_ * sn4_[u_]; } } } \
        _Pragma("unroll") for (int e_ = 0; e_ < 4; ++e_) { u32x4 w_; w_.x = pk2(kf_[8 * e_], kf_[8 * e_ + 1]); w_.y = pk2(kf_[8 * e_ + 2], kf_[8 * e_ + 3]); w_.z = pk2(kf_[8 * e_ + 4], kf_[8 * e_ + 5]); w_.w = pk2(kf_[8 * e_ + 6], kf_[8 * e_ + 7]); \
            *(LAS u32x4*)(dK_ + e_ * 16) = w_; } } while (0)
    __syncthreads();
    if (c0 > 0) { DIL_LOAD(c0 - 1); DIL_STAGE(c0 - 1); }
    else { const int row_ = 128 + srow; const u32x4 z = (u32x4){0u, 0u, 0u, 0u};
#pragma unroll
        for (int e = 0; e < 4; ++e) { *(LAS u32x4*)(Kl + row_ * KVS + sq * 64 + e * 16) = z; *(LAS u32x4*)(Vl + row_ * KVS + sq * 64 + e * 16) = z; } }
    DIL_LOAD(c0); DIL_LOADQ(c0);
    for (int c = c0; c < c0 + nblk; ++c) {
        if (c > c0) __syncthreads();
        DIL_STAGE(c);
        const int p = (c * 128 + qi) * d + r;
        bf16_t* qrow = cols + (size_t)(bl * SEQ + p) * IN_A + qoff;
        bf16x8 qf[4];
        const bool lead = wave < 4;
        if (lead) {
        {
            float qv[4][8]; float ss = 0.f;
#pragma unroll
            for (int ks = 0; ks < 4; ++ks) { const u32x4 wq = qr[ks];
                qv[ks][0] = bflo(wq.x); qv[ks][1] = bfhi(wq.x); qv[ks][2] = bflo(wq.y); qv[ks][3] = bfhi(wq.y); qv[ks][4] = bflo(wq.z); qv[ks][5] = bfhi(wq.z); qv[ks][6] = bflo(wq.w); qv[ks][7] = bfhi(wq.w); }
#pragma unroll
            for (int ks = 0; ks < 4; ++ks)
#pragma unroll
                for (int e = 0; e < 8; ++e) ss += qv[ks][e] * qv[ks][e];
            ss += __shfl_xor(ss, 16); ss += __shfl_xor(ss, 32);
            const float rstd = rsqrtf(ss * (1.f / 128.f) + EPS) * QSCALE;
#pragma unroll
            for (int ks = 0; ks < 4; ++ks) { const f32x4 g0 = *(const GAS f32x4*)(qg + ks * 32 + quad * 8), g1 = *(const GAS f32x4*)(qg + ks * 32 + quad * 8 + 4);
                qv[ks][0] *= rstd * g0[0]; qv[ks][1] *= rstd * g0[1]; qv[ks][2] *= rstd * g0[2]; qv[ks][3] *= rstd * g0[3];
                qv[ks][4] *= rstd * g1[0]; qv[ks][5] *= rstd * g1[1]; qv[ks][6] *= rstd * g1[2]; qv[ks][7] *= rstd * g1[3]; }
            const GAS float* rt = rotg + (size_t)(bglob * SEQ + p) * 32 + (quad & 1) * 8;
            const f32x4 c0 = *(const GAS f32x4*)rt, c1 = *(const GAS f32x4*)(rt + 4), s0 = *(const GAS f32x4*)(rt + 16), s1 = *(const GAS f32x4*)(rt + 20);
            const bool second = quad >= 2;
#pragma unroll
            for (int e = 0; e < 8; ++e) {
                const float cs = e < 4 ? c0[e & 3] : c1[e & 3], sn = e < 4 ? s0[e & 3] : s1[e & 3];
                const float mine = qv[0][e], other = __shfl_xor(mine, 32);
                qv[0][e] = second ? (mine * cs + other * sn) : (mine * cs - other * sn);
            }
#pragma unroll
            for (int ks = 0; ks < 4; ++ks) { u32x4 wq; wq.x = pk2(qv[ks][0], qv[ks][1]); wq.y = pk2(qv[ks][2], qv[ks][3]); wq.z = pk2(qv[ks][4], qv[ks][5]); wq.w = pk2(qv[ks][6], qv[ks][7]); qf[ks] = __builtin_bit_cast(bf16x8, wq); }
        }
            if (c + 1 < c0 + nblk) { DIL_LOAD(c + 1); DIL_LOADQ(c + 1); }
        }
        __syncthreads();
        if (!lead) {
        {
            float qv[4][8]; float ss = 0.f;
#pragma unroll
            for (int ks = 0; ks < 4; ++ks) { const u32x4 wq = qr[ks];
                qv[ks][0] = bflo(wq.x); qv[ks][1] = bfhi(wq.x); qv[ks][2] = bflo(wq.y); qv[ks][3] = bfhi(wq.y); qv[ks][4] = bflo(wq.z); qv[ks][5] = bfhi(wq.z); qv[ks][6] = bflo(wq.w); qv[ks][7] = bfhi(wq.w); }
#pragma unroll
            for (int ks = 0; ks < 4; ++ks)
#pragma unroll
                for (int e = 0; e < 8; ++e) ss += qv[ks][e] * qv[ks][e];
            ss += __shfl_xor(ss, 16); ss += __shfl_xor(ss, 32);
            const float rstd = rsqrtf(ss * (1.f / 128.f) + EPS) * QSCALE;
#pragma unroll
            for (int ks = 0; ks < 4; ++ks) { const f32x4 g0 = *(const GAS f32x4*)(qg + ks * 32 + quad * 8), g1 = *(const GAS f32x4*)(qg + ks * 32 + quad * 8 + 4);
                qv[ks][0] *= rstd * g0[0]; qv[ks][1] *= rstd * g0[1]; qv[ks][2] *= rstd * g0[2]; qv[ks][3] *= rstd * g0[3];
                qv[ks][4] *= rstd * g1[0]; qv[ks][5] *= rstd * g1[1]; qv[ks][6] *= rstd * g1[2]; qv[ks][7] *= rstd * g1[3]; }
            const GAS float* rt = rotg + (size_t)(bglob * SEQ + p) * 32 + (quad & 1) * 8;
            const f32x4 c0 = *(const GAS f32x4*)rt, c1 = *(const GAS f32x4*)(rt + 4), s0 = *(const GAS f32x4*)(rt + 16), s1 = *(const GAS f32x4*)(rt + 20);
            const bool second = quad >= 2;
#pragma unroll
            for (int e = 0; e < 8; ++e) {
                const float cs = e < 4 ? c0[e & 3] : c1[e & 3], sn = e < 4 ? s0[e & 3] : s1[e & 3];
                const float mine = qv[0][e], other = __shfl_xor(mine, 32);
                qv[0][e] = second ? (mine * cs + other * sn) : (mine * cs - other * sn);
            }
#pragma unroll
            for (int ks = 0; ks < 4; ++ks) { u32x4 wq; wq.x = pk2(qv[ks][0], qv[ks][1]); wq.y = pk2(qv[ks][2], qv[ks][3]); wq.z = pk2(qv[ks][4], qv[ks][5]); wq.w = pk2(qv[ks][6], qv[ks][7]); qf[ks] = __builtin_bit_cast(bf16x8, wq); }
        }
            if (c + 1 < c0 + nblk) { DIL_LOAD(c + 1); DIL_LOADQ(c + 1); }
        }
        f32x4 o[8]; float m, l;
        attn_core<9, true>(Kl, Vl, qf, i0, qi, c == 0, (c & 1) ? 0 : 128, o, m, l);
        const float inv = 1.f / l;
#pragma unroll
        for (int dt = 0; dt < 8; dt += 2) {
            u32x2 w0, w1; w0.x = pk2(o[dt][0] * inv, o[dt][1] * inv); w0.y = pk2(o[dt][2] * inv, o[dt][3] * inv); w1.x = pk2(o[dt + 1][0] * inv, o[dt + 1][1] * inv); w1.y = pk2(o[dt + 1][2] * inv, o[dt + 1][3] * inv);
            *(u32x4*)(qrow + (dt + (quad & 1)) * 16 + (quad >> 1) * 8) = swap16_pack(w0, w1); }
        if (quad == 0) lse[(size_t)(bl * SEQ + p) * 24 + g * 8 + h] = (m + __log2f(l)) * LN2;
    }
#undef DIL_LOAD
#undef DIL_LOADQ
#undef DIL_STAGE
}

DI void mem_attn_unit(LAS unsigned char* lds, bf16_t* cols, int ldc, int qmoff, int gmoff, const bf16_t* kvm, int lay, const float* qgain, const float* kgain, int unit, int bbase, int nq) {
    const int tid = launder_tid(), lane = tid & 63, wave = tid >> 6, l15 = lane & 15, quad = lane >> 4;
    const int nsub = 16 / nq, qsub = unit % nsub, bh = unit / nsub, h = bh & 3, bl = bh >> 2;
    const GAS float* qgg = launder_g(qgain); const GAS float* kgg = launder_g(kgain); const GAS bf16_t* kvmg = launder_g(kvm);
    const int bglob = bbase + bl;
    LAS unsigned char* Kl = lds; LAS unsigned char* Vl = lds + 256 * KVS;
    __syncthreads();
    {
        const int j = tid >> 1, half = tid & 1;
        LAS unsigned char* dK = Kl + j * KVS + half * 128; LAS unsigned char* dV = Vl + j * KVS + half * 128;
        const GAS bf16_t* rowp = kvmg + (size_t)(bglob * 256 + j) * 4096 + lay * 1024 + h * 128 + half * 64;
        const GAS u32x4* ks = (const GAS u32x4*)rowp; const GAS u32x4* vs = (const GAS u32x4*)(rowp + 512);
        u32x4 kr[8], vr[8];
#pragma unroll
        for (int e = 0; e < 8; ++e) { kr[e] = ks[e]; vr[e] = vs[e]; }
#pragma unroll
        for (int e = 0; e < 8; ++e) *(LAS u32x4*)(dV + e * 16) = vr[e];
        float ss = 0.f;
#pragma unroll
        for (int e = 0; e < 8; ++e)
#pragma unroll
            for (int w = 0; w < 4; ++w) { const float a = bflo(kr[e][w]), b = bfhi(kr[e][w]); ss += a * a + b * b; }
        ss += __shfl_xor(ss, 1);
        const float rstd = rsqrtf(ss * (1.f / 128.f) + EPS);
        const GAS f32x4* gp = (const GAS f32x4*)(kgg + half * 64);
#pragma unroll
        for (int e = 0; e < 8; ++e) {
            const f32x4 g0 = gp[2 * e], g1 = gp[2 * e + 1];
            u32x4 w;
            w.x = pk2(bflo(kr[e].x) * rstd * g0[0], bfhi(kr[e].x) * rstd * g0[1]); w.y = pk2(bflo(kr[e].y) * rstd * g0[2], bfhi(kr[e].y) * rstd * g0[3]);
            w.z = pk2(bflo(kr[e].z) * rstd * g1[0], bfhi(kr[e].z) * rstd * g1[1]); w.w = pk2(bflo(kr[e].w) * rstd * g1[2], bfhi(kr[e].w) * rstd * g1[3]);
            *(LAS u32x4*)(dK + e * 16) = w;
        }
    }
    u32x4 qr[4];
#define MEM_LOADQ(qt_) do { const bf16_t* qp_ = cols + (size_t)(bl * SEQ + (qt_) * 128 + wave * 16 + l15) * ldc + qmoff + h * 128; \
        _Pragma("unroll") for (int ks_ = 0; ks_ < 4; ++ks_) qr[ks_] = *(const u32x4*)(qp_ + ks_ * 32 + quad * 8); } while (0)
    MEM_LOADQ(qsub * nq);
    __syncthreads();
    if (wave >= 4) __builtin_amdgcn_s_sleep(10);
    for (int qq = 0; qq < nq; ++qq) {
        const int qt = qsub * nq + qq;
        const int p = qt * 128 + wave * 16 + l15;
        bf16_t* rowp = cols + (size_t)(bl * SEQ + p) * ldc;
        bf16x8 qf[4];
        {
            float qv[4][8]; float ss = 0.f;
#pragma unroll
            for (int ks = 0; ks < 4; ++ks) { const u32x4 w = qr[ks];
                qv[ks][0] = bflo(w.x); qv[ks][1] = bfhi(w.x); qv[ks][2] = bflo(w.y); qv[ks][3] = bfhi(w.y); qv[ks][4] = bflo(w.z); qv[ks][5] = bfhi(w.z); qv[ks][6] = bflo(w.w); qv[ks][7] = bfhi(w.w); }
#pragma unroll
            for (int ks = 0; ks < 4; ++ks)
#pragma unroll
                for (int e = 0; e < 8; ++e) ss += qv[ks][e] * qv[ks][e];
            ss += __shfl_xor(ss, 16); ss += __shfl_xor(ss, 32);
            const float rstd = rsqrtf(ss * (1.f / 128.f) + EPS) * QSCALE;
#pragma unroll
            for (int ks = 0; ks < 4; ++ks) { const f32x4 g0 = *(const GAS f32x4*)(qgg + ks * 32 + quad * 8), g1 = *(const GAS f32x4*)(qgg + ks * 32 + quad * 8 + 4);
                u32x4 w; w.x = pk2(qv[ks][0] * rstd * g0[0], qv[ks][1] * rstd * g0[1]); w.y = pk2(qv[ks][2] * rstd * g0[2], qv[ks][3] * rstd * g0[3]);
                w.z = pk2(qv[ks][4] * rstd * g1[0], qv[ks][5] * rstd * g1[1]); w.w = pk2(qv[ks][6] * rstd * g1[2], qv[ks][7] * rstd * g1[3]); qf[ks] = __builtin_bit_cast(bf16x8, w); }
        }
        if (qq + 1 < nq) MEM_LOADQ(qt + 1);
        bf16_t* grow = rowp + gmoff + h * 128;
        u32x4 gwv[4];
#pragma unroll
        for (int dp = 0; dp < 4; ++dp) gwv[dp] = *(const u32x4*)(grow + (2 * dp + (quad & 1)) * 16 + (quad >> 1) * 8);
        f32x4 o[8]; float m, l;
        attn_core<16, false>(Kl, Vl, qf, 0, 0, false, 0, o, m, l);
        const float inv = 1.f / l;
#pragma unroll
        for (int dp = 0; dp < 4; ++dp) {
            const int dt = 2 * dp;
            u32x2 w0, w1; w0.x = pk2(o[dt][0] * inv, o[dt][1] * inv); w0.y = pk2(o[dt][2] * inv, o[dt][3] * inv); w1.x = pk2(o[dt + 1][0] * inv, o[dt + 1][1] * inv); w1.y = pk2(o[dt + 1][2] * inv, o[dt + 1][3] * inv);
            const u32x4 ov = swap16_pack(w0, w1), gw = gwv[dp];
            u32x4 y;
#pragma unroll
            for (int e = 0; e < 4; ++e) y[e] = pk2(bflo(ov[e]) * silu(bflo(gw[e])), bfhi(ov[e]) * silu(bfhi(gw[e])));
            *(u32x4*)(grow + (dt + (quad & 1)) * 16 + (quad >> 1) * 8) = y;
        }
    }
#undef MEM_LOADQ
}

DI void gla_item(LAS unsigned char* lds, bf16_t* cols, const float* lb, int item) {
    const int tid = launder_tid(), lane = tid & 63, wave = tid >> 6, l15 = lane & 15, quad = lane >> 4;
    const int vh = item & 1, h = (item >> 1) & 7, b = item >> 4;
    LAS unsigned char* RQ = lds; LAS unsigned char* RF = RQ + 16384; LAS unsigned char* QT = RF + 16384; LAS unsigned char* KT = QT + 17408; LAS unsigned char* QG = KT + 17408;
    LAS unsigned char* KD = QG + 17408; LAS unsigned char* VT = KD + 18432; LAS unsigned char* AT = VT + 9216; LAS unsigned char* ST = AT + 9216; LAS unsigned char* GL = ST + 17408; LAS unsigned char* SEG = GL + 512;
    bf16_t* base = cols + (size_t)b * SEQ * IN_B;
    const int qcol = h * 128, fcol = 1024 + h * 128, vcol = 2048 + h * 128 + vh * 64;
    const int ek = tid & 127, eseg = tid >> 7;
    const GAS float* lbg = launder_g(lb);
    const float lbk = lbg[h * 128 + ek], omlb = 1.f - lbk;
    f32x4 sacc[4];
#pragma unroll
    for (int i = 0; i < 4; ++i) sacc[i] = (f32x4){0.f, 0.f, 0.f, 0.f};
    __syncthreads();
    for (int i = tid; i < 17408 / 16; i += NTHREADS) ((LAS u32x4*)ST)[i] = (u32x4){0u, 0u, 0u, 0u};
    const int lrow = tid >> 3, lc16 = tid & 7, vt_t = tid & 63, vt_v8 = tid >> 6;
    u32x4 pq0, pq1, pf0, pf1, pv;
#define GLA_LOAD(cc) do { const bf16_t* rp = base + (size_t)((cc) * 64 + lrow) * IN_B; \
        pq0 = *(const u32x4*)(rp + qcol + lc16 * 8); pq1 = *(const u32x4*)(rp + qcol + 64 + lc16 * 8); \
        pf0 = *(const u32x4*)(rp + fcol + lc16 * 8); pf1 = *(const u32x4*)(rp + fcol + 64 + lc16 * 8); \
        pv = *(const u32x4*)(base + (size_t)((cc) * 64 + vt_t) * IN_B + vcol + vt_v8 * 8); } while (0)
#define GLA_STORE() do { *(LAS u32x4*)(RQ + lrow * 256 + lc16 * 16) = pq0; *(LAS u32x4*)(RQ + lrow * 256 + 128 + lc16 * 16) = pq1; \
        *(LAS u32x4*)(RF + lrow * 256 + lc16 * 16) = pf0; *(LAS u32x4*)(RF + lrow * 256 + 128 + lc16 * 16) = pf1; \
        LAS bf16_t* vt = (LAS bf16_t*)VT + (vt_v8 * 8) * 72 + vt_t; \
        vt[0 * 72] = (bf16_t)(pv.x & 0xffffu); vt[1 * 72] = (bf16_t)(pv.x >> 16); vt[2 * 72] = (bf16_t)(pv.y & 0xffffu); vt[3 * 72] = (bf16_t)(pv.y >> 16); \
        vt[4 * 72] = (bf16_t)(pv.z & 0xffffu); vt[5 * 72] = (bf16_t)(pv.z >> 16); vt[6 * 72] = (bf16_t)(pv.w & 0xffffu); vt[7 * 72] = (bf16_t)(pv.w >> 16); } while (0)
    GLA_LOAD(0); GLA_STORE();
    for (int c = 0; c < 32; ++c) {
        __syncthreads();
        if (c + 1 < 32) GLA_LOAD(c + 1);
        float cp[16], kk[16], qq[16]; float run = 1.f;
#pragma unroll
        for (int tt = 0; tt < 16; ++tt) { const int t = eseg * 16 + tt;
            const float z = bf2f(((LAS bf16_t*)RF)[t * 128 + ek]);
            const float sg = __builtin_amdgcn_rcpf(1.f + __expf(-z)); const float fg = lbk + omlb * sg;
            run *= fg; cp[tt] = run; kk[tt] = 1.f - fg; qq[tt] = bf2f(((LAS bf16_t*)RQ)[t * 128 + ek]); }
        ((LAS float*)SEG)[eseg * 128 + ek] = run;
        __syncthreads();
        const float s0 = ((LAS float*)SEG)[ek], s1 = ((LAS float*)SEG)[128 + ek], s2 = ((LAS float*)SEG)[256 + ek], s3 = ((LAS float*)SEG)[384 + ek];
        const float pmid = s0 * s1, ptail = s2 * s3;
        const float e1s = (eseg == 0) ? __builtin_amdgcn_rcpf(s0) * __builtin_amdgcn_rcpf(s1) : (eseg == 1) ? __builtin_amdgcn_rcpf(s1) : (eseg == 2) ? 1.f : s2;
        if (eseg == 0) ((LAS float*)GL)[ek] = pmid * ptail;
        unsigned kdp[8];
#pragma unroll
        for (int tt = 0; tt < 16; tt += 2) {
            float kd2[2];
#pragma unroll
            for (int u = 0; u < 2; ++u) { const int t = eseg * 16 + tt + u;
                const float e1 = cp[tt + u] * e1s, r1 = __builtin_amdgcn_rcpf(e1);
                ((LAS bf16_t*)QG)[t * 136 + ek] = f2bf(qq[tt + u] * e1 * pmid);
                ((LAS bf16_t*)QT)[t * 136 + ek] = f2bf(qq[tt + u] * e1);
                ((LAS bf16_t*)KT)[t * 136 + ek] = f2bf(kk[tt + u] * r1);
                kd2[u] = kk[tt + u] * (ptail * r1); }
            kdp[tt >> 1] = pk2(kd2[0], kd2[1]);
        }
        *(LAS u32x4*)(KD + ek * 144 + eseg * 32) = (u32x4){kdp[0], kdp[1], kdp[2], kdp[3]};
        *(LAS u32x4*)(KD + ek * 144 + eseg * 32 + 16) = (u32x4){kdp[4], kdp[5], kdp[6], kdp[7]};
        __syncthreads();
        const int tt_ = wave >> 1;
        {
            bf16x8 bq[4];
#pragma unroll
            for (int ks = 0; ks < 4; ++ks) bq[ks] = *(const LAS bf16x8*)(QT + (16 * tt_ + l15) * 272 + ks * 64 + quad * 16);
#pragma unroll
            for (int u = 0; u < 2; ++u) { const int st = 2 * (wave & 1) + u;
                f32x4 a = (f32x4){0.f, 0.f, 0.f, 0.f};
                if (st <= tt_) {
#pragma unroll
                    for (int ks = 0; ks < 4; ++ks) { const bf16x8 ka = *(const LAS bf16x8*)(KT + (16 * st + l15) * 272 + ks * 64 + quad * 16); a = mfma16(ka, bq[ks], a); }
                }
                const int tq = 16 * tt_ + l15, sb = 16 * st + 4 * quad;
                const float a0 = (st <= tt_ && sb + 0 <= tq) ? a[0] : 0.f, a1 = (st <= tt_ && sb + 1 <= tq) ? a[1] : 0.f, a2 = (st <= tt_ && sb + 2 <= tq) ? a[2] : 0.f, a3 = (st <= tt_ && sb + 3 <= tq) ? a[3] : 0.f;
                u32x2 w; w.x = pk2(a0, a1); w.y = pk2(a2, a3);
                *(LAS u32x2*)(AT + tq * 144 + sb * 2) = w; }
        }
        __syncthreads();
        {
            bf16x8 bq[4], ba[2];
#pragma unroll
            for (int ks = 0; ks < 4; ++ks) bq[ks] = *(const LAS bf16x8*)(QG + (16 * tt_ + l15) * 272 + ks * 64 + quad * 16);
#pragma unroll
            for (int ks = 0; ks < 2; ++ks) ba[ks] = *(const LAS bf16x8*)(AT + (16 * tt_ + l15) * 144 + ks * 64 + quad * 16);
#pragma unroll
            for (int u = 0; u < 2; ++u) { const int vt = 2 * (wave & 1) + u;
                f32x4 a = (f32x4){0.f, 0.f, 0.f, 0.f};
#pragma unroll
                for (int ks = 0; ks < 4; ++ks) { const bf16x8 sa = *(const LAS bf16x8*)(ST + (16 * vt + l15) * 272 + ks * 64 + quad * 16); a = mfma16(sa, bq[ks], a); }
#pragma unroll
                for (int ks = 0; ks < 2; ++ks) { const bf16x8 va = *(const LAS bf16x8*)(VT + (16 * vt + l15) * 144 + ks * 64 + quad * 16); a = mfma16(va, ba[ks], a); }
                u32x2 w; w.x = pk2(a[0], a[1]); w.y = pk2(a[2], a[3]);
                *(u32x2*)(base + (size_t)(c * 64 + 16 * tt_ + l15) * IN_B + vcol + 16 * vt + 4 * quad) = w; }
        }
        {
            bf16x8 ka[2];
#pragma unroll
            for (int ks = 0; ks < 2; ++ks) ka[ks] = *(const LAS bf16x8*)(KD + (16 * wave + l15) * 144 + ks * 64 + quad * 16);
            const f32x4 gl = *(const LAS f32x4*)(GL + (16 * wave + 4 * quad) * 4);
#pragma unroll
            for (int vt = 0; vt < 4; ++vt) { sacc[vt] = sacc[vt] * gl;
#pragma unroll
                for (int ks = 0; ks < 2; ++ks) { const bf16x8 vb = *(const LAS bf16x8*)(VT + (16 * vt + l15) * 144 + ks * 64 + quad * 16); sacc[vt] = mfma16(ka[ks], vb, sacc[vt]); } }
        }
        __syncthreads();
#pragma unroll
        for (int vt = 0; vt < 4; ++vt) { u32x2 w; w.x = pk2(sacc[vt][0], sacc[vt][1]); w.y = pk2(sacc[vt][2], sacc[vt][3]);
            *(LAS u32x2*)(ST + (16 * vt + l15) * 272 + (16 * wave + 4 * quad) * 2) = w; }
        if (c + 1 < 32) GLA_STORE();
    }
#undef GLA_LOAD
#undef GLA_STORE
}

DI void gate_A(bf16_t* cols, const float* lse, int ntok, int bid, int nb) {
    const int tid = launder_tid(), sub = tid & 127, h = sub >> 4, d8 = (sub & 15) * 8;
    constexpr int U = 4;
    for (int tok0 = bid * 4 + (tid >> 7); tok0 < ntok; tok0 += nb * 4 * U) {
        u32x4 o0[U], o1[U], o2[U], gt[U]; float l0[U], l1[U], l2[U];
#pragma unroll
        for (int u = 0; u < U; ++u) { const int tok = min(tok0 + u * nb * 4, ntok - 1); const bf16_t* rowp = cols + (size_t)tok * IN_A;
            l0[u] = lse[(size_t)tok * 24 + h]; l1[u] = lse[(size_t)tok * 24 + 8 + h]; l2[u] = lse[(size_t)tok * 24 + 16 + h];
            o0[u] = *(const u32x4*)(rowp + h * 128 + d8); o1[u] = *(const u32x4*)(rowp + 1024 + h * 128 + d8); o2[u] = *(const u32x4*)(rowp + 2048 + h * 128 + d8);
            gt[u] = *(const u32x4*)(rowp + 9728 + h * 128 + d8); }
#pragma unroll
        for (int u = 0; u < U; ++u) { const int tok = tok0 + u * nb * 4; if (tok >= ntok) continue;
            const float m = fmaxf(l0[u], fmaxf(l1[u], l2[u]));
            float w0 = __expf(l0[u] - m), w1 = __expf(l1[u] - m), w2 = __expf(l2[u] - m);
            const float inv = 1.f / (w0 + w1 + w2); w0 *= inv; w1 *= inv; w2 *= inv;
            u32x4 y;
#pragma unroll
            for (int e = 0; e < 4; ++e) {
                const float ylo = (w0 * bflo(o0[u][e]) + w1 * bflo(o1[u][e]) + w2 * bflo(o2[u][e])) * silu(bflo(gt[u][e]));
                const float yhi = (w0 * bfhi(o0[u][e]) + w1 * bfhi(o1[u][e]) + w2 * bfhi(o2[u][e])) * silu(bfhi(gt[u][e]));
                y[e] = pk2(ylo, yhi); }
            *(u32x4*)(cols + (size_t)tok * IN_A + 9728 + h * 128 + d8) = y; }
    }
}
DI void gate_B(bf16_t* cols, const float* ogain, int ntok, int bid, int nb) {
    const int tid = launder_tid(), sub = tid & 127, h = sub >> 4, d8 = (sub & 15) * 8;
    const GAS float* ogg = launder_g(ogain);
    const f32x4 g0 = *(const GAS f32x4*)(ogg + d8), g1 = *(const GAS f32x4*)(ogg + d8 + 4);
    constexpr int U = 4;
    for (int tok0 = bid * 4 + (tid >> 7); tok0 < ntok; tok0 += nb * 4 * U) {
        u32x4 ow[U], gt[U];
#pragma unroll
        for (int u = 0; u < U; ++u) { const bf16_t* rowp = cols + (size_t)(tok0 + u * nb * 4) * IN_B;
            ow[u] = *(const u32x4*)(rowp + 2048 + h * 128 + d8); gt[u] = *(const u32x4*)(rowp + 3584 + h * 128 + d8); }
#pragma unroll
        for (int u = 0; u < U; ++u) {
            float ov[8]; float ss = 0.f;
#pragma unroll
            for (int e = 0; e < 4; ++e) { ov[2 * e] = bflo(ow[u][e]); ov[2 * e + 1] = bfhi(ow[u][e]); }
#pragma unroll
            for (int e = 0; e < 8; ++e) ss += ov[e] * ov[e];
            ss += __shfl_xor(ss, 1); ss += __shfl_xor(ss, 2); ss += __shfl_xor(ss, 4); ss += __shfl_xor(ss, 8);
            const float rstd = rsqrtf(ss * (1.f / 128.f) + EPS);
            u32x4 y;
            y[0] = pk2(ov[0] * rstd * g0[0] * silu(bflo(gt[u][0])), ov[1] * rstd * g0[1] * silu(bfhi(gt[u][0])));
            y[1] = pk2(ov[2] * rstd * g0[2] * silu(bflo(gt[u][1])), ov[3] * rstd * g0[3] * silu(bfhi(gt[u][1])));
            y[2] = pk2(ov[4] * rstd * g1[0] * silu(bflo(gt[u][2])), ov[5] * rstd * g1[1] * silu(bfhi(gt[u][2])));
            y[3] = pk2(ov[6] * rstd * g1[2] * silu(bflo(gt[u][3])), ov[7] * rstd * g1[3] * silu(bfhi(gt[u][3])));
            *(u32x4*)(cols + (size_t)(tok0 + u * nb * 4) * IN_B + 3584 + h * 128 + d8) = y; }
    }
}

constexpr int NSTEPS = 26;
__device__ const unsigned char kSteps[NSTEPS][4] = {
    {0, 0, 0, 0}, {1, 0, 0, 0},
    {2, 0, 0, 0}, {3, 0, 0, 0}, {4, 0, 0, 0}, {5, 0, 0, 0}, {2, 0, 1, 0}, {3, 0, 1, 0}, {4, 0, 1, 1}, {5, 0, 1, 0},
    {2, 1, 0, 0}, {3, 1, 0, 0}, {4, 1, 0, 1}, {5, 1, 0, 0},
    {2, 2, 0, 0}, {3, 2, 0, 0}, {4, 2, 0, 0}, {5, 2, 0, 0}, {2, 2, 1, 0}, {3, 2, 1, 0}, {4, 2, 1, 1}, {5, 2, 1, 0},
    {2, 3, 0, 0}, {3, 3, 0, 0}, {4, 3, 0, 0}, {5, 3, 0, 0}};

__global__ void __launch_bounds__(NTHREADS, 2) fwd_megakernel(Params P) {
    extern __shared__ __attribute__((aligned(16))) unsigned char lds_raw[];
    LAS unsigned char* lds = (LAS unsigned char*)lds_raw;
    cg::grid_group grid = cg::this_grid();
    const int bid = blockIdx.x, nb = gridDim.x, tid = threadIdx.x;
    unsigned char* ws = P.ws;
    const float* x_in = P.in[0]; const float* mem = P.in[1]; const int* positions = (const int*)P.in[2];
    const float* norm_gain = P.in[3]; const float* w_in_a = P.in[4]; const float* q_gain_a = P.in[5]; const float* k_gain_a = P.in[6]; const float* w_out_a = P.in[7];
    const float* w_in_b = P.in[8]; const float* lb_logits = P.in[9]; const float* o_gain_b = P.in[10]; const float* w_out_b = P.in[11];
    const float* mem_norm_gain = P.in[12]; const float* w_mem_kv = P.in[13]; const float* mem_q_gain = P.in[14]; const float* mem_k_gain = P.in[15];
    bf16_t* WinT = (bf16_t*)(ws + WS_WIN); bf16_t* WoutT = (bf16_t*)(ws + WS_WOUT); bf16_t* XN = (bf16_t*)(ws + WS_XN); bf16_t* KVM = (bf16_t*)(ws + WS_KVM);
    bf16_t* MEMN = (bf16_t*)(ws + WS_MEMN); bf16_t* WkvT = (bf16_t*)(ws + WS_WKV); float* LSE = (float*)(ws + WS_LSE); float* LB = (float*)(ws + WS_LB); bf16_t* COLS = (bf16_t*)(ws + WS_COLS);
    float* ROT = (float*)(ws + WS_ROT);
    float* SSQ = (float*)(ws + WS_SSQ); bf16_t* WoutT2 = (bf16_t*)(ws + WS_WOUT2);
    float* out = P.out;
    volatile LAS unsigned* bst = (volatile LAS unsigned*)(lds + LDS_BYTES - 16);
    if (tid < 4) bst[tid] = 0u;
    __syncthreads();
    const XcdBarrier xbar = xcd_barrier_post((unsigned*)(ws + WS_BAR), bst);

    for (int step = 0; step < NSTEPS; ++step) {
        const int op = kSteps[step][0], l = kSteps[step][1], grp = kSteps[step][2];
        const int j = l >> 1; const bool isA = (l & 1) == 0;
        if (op == 0) {
            convert_wT(lds, w_in_a, norm_gain, WinT, DM, IN_A, bid, nb);
            convert_wT(lds, w_out_a, nullptr, WoutT, MIXW, DM, bid, nb);
            prep_rows(x_in, XN, SSQ, T_TOK, bid, nb);
            for (int q = 0; q < 4; ++q) convert_wT(lds, w_mem_kv + (size_t)q * DM * 1024, mem_norm_gain + q * DM, WkvT + (size_t)q * 1024 * DM, DM, 1024, bid, nb);
            norm_rows(mem, MEMN, 4096, bid, nb);
            {
                for (int e = bid * NTHREADS + launder_tid(); e < T_TOK * 16; e += nb * NTHREADS) {
                    const int tok = e >> 4, i = e & 15; float cs, sn; rot_cs(positions[tok], kRotF[i], cs, sn);
                    ROT[(size_t)tok * 32 + i] = cs; ROT[(size_t)tok * 32 + 16 + i] = sn; }
                for (int c = bid * NTHREADS + launder_tid(); c < 1024; c += nb * NTHREADS) {
                    const float a0 = lb_logits[c], a1 = lb_logits[1024 + c], a2 = lb_logits[2048 + c], a3 = lb_logits[3072 + c];
                    const float m = fmaxf(fmaxf(a0, a1), fmaxf(a2, a3));
                    const float e0 = __expf(a0 - m), e1 = __expf(a1 - m), e2 = __expf(a2 - m), e3 = __expf(a3 - m), inv = 1.f / (e0 + e1 + e2 + e3);
                    LB[c] = e1 * inv; LB[1024 + c] = (e1 + e2 + e3) * inv;
                }
            }
        } else if (op == 1 || op == 2 || op == 5) {
            pg8::Gemm g; pg8::Epi E; E.O = nullptr; E.ldc = 0; E.ssq_in = nullptr; E.X = nullptr; E.C = nullptr; E.ssq_out = nullptr;
            if (op == 1)      { g.A = MEMN; g.Bt = WkvT; g.M = 4096; g.N = 4096; g.K = DM; g.lda = DM; E.mode = 0; E.O = KVM; E.ldc = 4096; }
            else if (op == 2) { const int ldc = isA ? IN_A : IN_B; g.A = XN + (size_t)grp * 16384 * DM; g.Bt = WinT; g.M = isA ? 16384 : T_TOK; g.N = ldc; g.K = DM; g.lda = DM; E.mode = 0; E.O = COLS; E.ldc = ldc;
                                E.ssq_in = SSQ + (size_t)grp * 16384 * 16; }
            else              { const int ldc = isA ? IN_A : IN_B; g.A = COLS + (isA ? 9728 : 3584); g.Bt = (l & 1) ? WoutT2 : WoutT; g.M = isA ? 16384 : T_TOK; g.N = DM; g.K = MIXW; g.lda = ldc; E.mode = 1;
                                E.X = XN + (size_t)grp * 16384 * DM;
                                if (l == 3) E.C = out + (size_t)grp * 16384 * DM; else E.ssq_out = SSQ + (size_t)grp * 16384 * 16; }
            pg8::StaticOrder S; S.init(g.M, g.N, nb, bid);
            pg8::gemm_phase(lds, g, S, E);
        } else if (op == 3) {
            if (isA) { for (int it = bid; it < 1536; it += nb) dil_chain(lds, COLS, LSE, ROT, q_gain_a + j * 384, k_gain_a + j * 384, it, grp); }
            else     { for (int it = bid; it < 256; it += nb) gla_item(lds, COLS, LB + j * 1024, it); }
            const int ldc = isA ? IN_A : IN_B, qmoff = isA ? 9216 : 3072, gmoff = isA ? (9728 + 1024) : (3584 + 1024), nq = isA ? 2 : 4;
            for (int it = bid; it < 256; it += nb) mem_attn_unit(lds, COLS, ldc, qmoff, gmoff, KVM, l, mem_q_gain + l * 128, mem_k_gain + l * 128, it, grp * 8, nq);
        } else {
            if (isA) gate_A(COLS, LSE, 16384, bid, nb); else gate_B(COLS, o_gain_b + j * 128, T_TOK, bid, nb);
            if (kSteps[step][3]) {
                const int l1 = l + 1, j1 = l1 >> 1; const bool a1 = (l1 & 1) == 0;
                const float* win = a1 ? w_in_a + (size_t)j1 * DM * IN_A : w_in_b + (size_t)j1 * DM * IN_B;
                const float* wout = a1 ? w_out_a + (size_t)j1 * MIXW * DM : w_out_b + (size_t)j1 * MIXW * DM;
                convert_wT(lds, win, norm_gain + l1 * DM, WinT, DM, a1 ? IN_A : IN_B, bid, nb);
                convert_wT(lds, wout, nullptr, (l1 & 1) ? WoutT2 : WoutT, MIXW, DM, bid, nb);
            }
        }
        if (op == 1) continue;
        if (nb > (1 << 20)) grid.sync();
        xcd_barrier(xbar);
    }
}

extern "C" void kernel_launch(void* const* d_in, const int* in_sizes, int n_in, void* d_out, int out_size, void* d_ws, size_t ws_size, hipStream_t stream) {
    static int grid_blocks = 0;
    if (grid_blocks == 0) {
        if (n_in != 16 || out_size != T_TOK * DM || ws_size < WS_END) { fprintf(stderr, "kernel_launch: unexpected shapes (n_in %d out %d ws %zu need %zu)\n", n_in, out_size, ws_size, (size_t)WS_END); grid_blocks = -1; return; }
        int dev = 0, cus = 0, per_cu = 0;
        (void)hipGetDevice(&dev);
        (void)hipDeviceGetAttribute(&cus, hipDeviceAttributeMultiprocessorCount, dev);
        if (hipFuncSetAttribute((const void*)fwd_megakernel, hipFuncAttributeMaxDynamicSharedMemorySize, LDS_BYTES) != hipSuccess) { fprintf(stderr, "kernel_launch: hipFuncSetAttribute failed\n"); grid_blocks = -1; return; }
        (void)hipOccupancyMaxActiveBlocksPerMultiprocessor(&per_cu, (const void*)fwd_megakernel, NTHREADS, LDS_BYTES);
        if (per_cu < 1) per_cu = 1;
        grid_blocks = cus * per_cu;
        (void)hipGetLastError();
    }
    if (grid_blocks < 0) return;
    if (hipMemsetAsync((char*)d_ws + WS_BAR, 0, XCD_BAR_WORDS * 4, stream) != hipSuccess) { fprintf(stderr, "kernel_launch: memset of barrier words failed\n"); return; }
    Params p{};
    for (int i = 0; i < 16; ++i) p.in[i] = (const float*)d_in[i];
    p.out = (float*)d_out; p.ws = (unsigned char*)d_ws;
    void* args[] = {&p};
    hipError_t e = hipLaunchCooperativeKernel((const void*)fwd_megakernel, dim3(grid_blocks), dim3(NTHREADS), args, LDS_BYTES, stream);
    if (e != hipSuccess) fprintf(stderr, "cooperative launch failed: %s (grid %d)\n", hipGetErrorString(e), grid_blocks);
}
```
